# Optimizing an MI355X kernel written in HIP

```python
import jax, jax.numpy as jnp
from jax import lax
import numpy as np

D_MODEL = 1024
BATCH = 2
SEQ = 8192
DEPTH = 1

D_MIX = D_MODEL
D_CONV = D_MIX // 2
D_GMLP = D_MIX - D_CONV
N_CONV_GROUPS = 8
N_GMLP_HEADS = 8
GMLP_HEAD_DIM = D_GMLP // N_GMLP_HEADS
CONV_WIDTH = 31
CHUNK = 128
N_PROJ = 2 * D_CONV + 2 * D_GMLP
N_KEYS = 128
N_EXPERTS = N_KEYS * N_KEYS
PEER_HEADS = 8
D_KEY = 256
D_HALF = D_KEY // 2
TOPK = 16
TOKEN_BLOCK = 128
N_COND = 6
EPS = 1e-6

kernel_name = "hybrid_conv_gmlp_peer_adaln"


def rms_norm(x, g):
    xf = x.astype(jnp.float32)
    y = xf * lax.rsqrt(jnp.mean(xf * xf, axis=-1, keepdims=True) + EPS)
    return (y * g.astype(jnp.float32)).astype(x.dtype)


def group_layer_norm(x, n_groups, g, b):
    shp = x.shape
    xf = x.astype(jnp.float32).reshape(shp[:-1] + (n_groups, shp[-1] // n_groups))
    mu = jnp.mean(xf, axis=-1, keepdims=True)
    var = jnp.mean(jnp.square(xf - mu), axis=-1, keepdims=True)
    y = ((xf - mu) * lax.rsqrt(var + EPS)).reshape(shp)
    return (y * g.astype(jnp.float32) + b.astype(jnp.float32)).astype(x.dtype)


def conformer_conv_groups(a_val, a_gate, conv_w, conv_b, g_ln, b_ln):
    a = a_val * jax.nn.sigmoid(a_gate)
    y = lax.conv_general_dilated(
        a, conv_w[:, None, :].astype(a.dtype), window_strides=(1,),
        padding=[(CONV_WIDTH - 1, 0)],
        dimension_numbers=('NWC', 'WIO', 'NWC'),
        feature_group_count=D_CONV) + conv_b
    y = group_layer_norm(y, N_CONV_GROUPS, g_ln, b_ln)
    return jax.nn.silu(y)


def gmlp_groups(z, w_s, b_s, g_ln, b_ln, mask):
    B, S, _ = z.shape
    z = jax.nn.gelu(z)
    u, v = jnp.split(z, 2, axis=-1)
    v = group_layer_norm(v, N_GMLP_HEADS, g_ln, b_ln)
    v = v.reshape(B, S // CHUNK, CHUNK, N_GMLP_HEADS, GMLP_HEAD_DIM)
    mixed = jnp.einsum('hts,bnshd->bnthd', w_s * mask, v)
    mixed = mixed + jnp.transpose(b_s)[None, None, :, :, None]
    return u * mixed.reshape(B, S, D_GMLP)


def peer_ffn(h, w_q, sub_keys, expert_u, expert_v):
    B, S, D = h.shape
    T = B * S
    hf = h.reshape(T, D)
    q = (hf @ w_q).reshape(T, PEER_HEADS, 2, D_HALF)
    s = jnp.einsum('thid,hind->thin', q, sub_keys)
    sv, si = lax.top_k(s, TOPK)
    cand = (sv[:, :, 0, :, None] + sv[:, :, 1, None, :]).reshape(T, PEER_HEADS, TOPK * TOPK)
    cidx = (si[:, :, 0, :, None] * N_KEYS + si[:, :, 1, None, :]).reshape(T, PEER_HEADS, TOPK * TOPK)
    top_s, pos = lax.top_k(cand, TOPK)
    eidx = jnp.take_along_axis(cidx, pos, axis=-1)
    gates = jax.nn.softmax(top_s.astype(jnp.float32), axis=-1).astype(h.dtype)
    nb = T // TOKEN_BLOCK

    def apply_block(args):
        hb, eb, gb = args
        u = expert_u[eb]
        act = jax.nn.gelu(jnp.einsum('thkd,td->thk', u, hb)) * gb
        return jnp.einsum('thk,thkd->td', act, expert_v[eb])

    y = lax.map(apply_block, (hf.reshape(nb, TOKEN_BLOCK, D),
                              eidx.reshape(nb, TOKEN_BLOCK, PEER_HEADS, TOPK),
                              gates.reshape(nb, TOKEN_BLOCK, PEER_HEADS, TOPK)))
    return y.reshape(B, S, D)


def setup_inputs(seed: int = 0) -> dict:
    key = jax.random.key(seed)
    ks = jax.random.split(key, 24)
    n = jax.random.normal
    L, D = DEPTH, D_MODEL
    return {
        "x": n(ks[0], (BATCH, SEQ, D), jnp.float32),
        "c": n(ks[1], (BATCH, D), jnp.float32),
        "w_ada": n(ks[2], (L, D, N_COND * D), jnp.float32) * (0.5 * D ** -0.5),
        "b_ada": n(ks[3], (L, N_COND * D), jnp.float32) * 0.02,
        "g_norm1": 1.0 + 0.02 * n(ks[4], (L, D), jnp.float32),
        "w_in": n(ks[5], (L, D, N_PROJ), jnp.float32) * D ** -0.5,
        "b_in": n(ks[6], (L, N_PROJ), jnp.float32) * 0.02,
        "conv_w": n(ks[7], (L, CONV_WIDTH, D_CONV), jnp.float32) * CONV_WIDTH ** -0.5,
        "conv_b": n(ks[8], (L, D_CONV), jnp.float32) * 0.02,
        "g_conv_ln": 1.0 + 0.02 * n(ks[9], (L, D_CONV), jnp.float32),
        "b_conv_ln": n(ks[10], (L, D_CONV), jnp.float32) * 0.02,
        "g_v_ln": 1.0 + 0.02 * n(ks[11], (L, D_GMLP), jnp.float32),
        "b_v_ln": n(ks[12], (L, D_GMLP), jnp.float32) * 0.02,
        "w_spatial": n(ks[13], (L, N_GMLP_HEADS, CHUNK, CHUNK), jnp.float32) * CHUNK ** -0.5,
        "b_spatial": 1.0 + 0.02 * n(ks[14], (L, N_GMLP_HEADS, CHUNK), jnp.float32),
        "w_out": n(ks[15], (L, D_MIX, D), jnp.float32) * D_MIX ** -0.5,
        "b_out": n(ks[16], (L, D), jnp.float32) * 0.02,
        "g_norm2": 1.0 + 0.02 * n(ks[17], (L, D), jnp.float32),
        "w_query": n(ks[18], (L, D, PEER_HEADS * D_KEY), jnp.float32) * D ** -0.5,
        "sub_keys": n(ks[19], (L, PEER_HEADS, 2, N_KEYS, D_HALF), jnp.float32) * D_HALF ** -0.5,
        "expert_u": n(ks[20], (L, N_EXPERTS, D), jnp.float32) * D ** -0.5,
        "expert_v": n(ks[21], (L, N_EXPERTS, D), jnp.float32) * PEER_HEADS ** -0.5,
        "g_final": 1.0 + 0.02 * n(ks[22], (D,), jnp.float32),
    }


def reference(x, c, w_ada, b_ada, g_norm1, w_in, b_in, conv_w, conv_b, g_conv_ln, b_conv_ln,
              g_v_ln, b_v_ln, w_spatial, b_spatial, w_out, b_out, g_norm2, w_query, sub_keys,
              expert_u, expert_v, g_final):
    mask = jnp.tril(jnp.ones((CHUNK, CHUNK), dtype=w_spatial.dtype))
    for l in range(DEPTH):
        cond = jax.nn.silu(c) @ w_ada[l] + b_ada[l]
        sh1, sc1, gt1, sh2, sc2, gt2 = jnp.split(cond[:, None, :], N_COND, axis=-1)
        h = rms_norm(x, g_norm1[l]) * (1.0 + sc1) + sh1
        p = h @ w_in[l] + b_in[l]
        a_val, a_gate, z = jnp.split(p, [D_CONV, 2 * D_CONV], axis=-1)
        ya = conformer_conv_groups(a_val, a_gate, conv_w[l], conv_b[l], g_conv_ln[l], b_conv_ln[l])
        yb = gmlp_groups(z, w_spatial[l], b_spatial[l], g_v_ln[l], b_v_ln[l], mask)
        y = jnp.concatenate([ya, yb], axis=-1) @ w_out[l] + b_out[l]
        x = x + gt1 * y
        h2 = rms_norm(x, g_norm2[l]) * (1.0 + sc2) + sh2
        x = x + gt2 * peer_ffn(h2, w_query[l], sub_keys[l], expert_u[l], expert_v[l])
    return rms_norm(x, g_final)
```

```cpp
#include <hip/hip_runtime.h>
#include <cstdio>
#include <cstdint>

constexpr int D = 1024, BATCH = 2, SEQ = 8192, T = BATCH * SEQ;
constexpr int DCONV = 512, DG = 512, NPROJ = 2048, CW = 31, CHUNK = 128;
constexpr int NKEYS = 128, NEXP = 16384, PH = 8, DKEY = 256, DHALF = 128, TOPK = 16;
constexpr float EPS = 1e-6f;

__device__ __forceinline__ float gelu_tanh(float x) { return 0.5f * x * (1.f + tanhf(0.7978845608028654f * (x + 0.044715f * x * x * x))); }
__device__ __forceinline__ float sigmoidf_(float x) { return 1.f / (1.f + expf(-x)); }
__device__ __forceinline__ int phase_tid() { int t = threadIdx.x; asm volatile("" : "+v"(t)); return t; }
__device__ __forceinline__ float wave_sum(float v) {
#pragma unroll
    for (int o = 1; o < 64; o <<= 1) v += __shfl_xor(v, o);
    return v;
}

typedef float f32x2 __attribute__((ext_vector_type(2)));
__device__ __forceinline__ float gelu_fast(float x) {
    const float z = x * (0.7978845608028654f + 0.035677408136300125f * x * x);
    return x * __builtin_amdgcn_rcpf(1.f + __builtin_amdgcn_exp2f(-2.885390081777927f * z));
}
#define SWZ(v, pat) __int_as_float(__builtin_amdgcn_ds_swizzle(__float_as_int(v), pat))
__device__ __forceinline__ float reduce16(const float (&s)[16], int lane) {
    float t[8];
#pragma unroll
    for (int k = 0; k < 8; ++k) { auto r = __builtin_amdgcn_permlane32_swap(__float_as_uint(s[k]), __float_as_uint(s[k + 8]), false, false); t[k] = __uint_as_float(r[0]) + __uint_as_float(r[1]); }
    const bool b4 = lane & 16, b3 = lane & 8, b2 = lane & 4;
    float u[4];
#pragma unroll
    for (int k = 0; k < 4; ++k) { const float keep = b4 ? t[k + 4] : t[k], send = b4 ? t[k] : t[k + 4]; u[k] = keep + SWZ(send, 0x401F); }
    float v[2];
#pragma unroll
    for (int k = 0; k < 2; ++k) { const float keep = b3 ? u[k + 2] : u[k], send = b3 ? u[k] : u[k + 2]; v[k] = keep + SWZ(send, 0x201F); }
    const float keep = b2 ? v[1] : v[0], send = b2 ? v[0] : v[1];
    float w = keep + SWZ(send, 0x101F);
    w += SWZ(w, 0x081F); w += SWZ(w, 0x041F);
    return w;
}
namespace pg8 {
#define PG8_LAS __attribute__((address_space(3)))
typedef unsigned short bf16_t;
typedef short bf16x8 __attribute__((ext_vector_type(8)));
typedef float f32x4 __attribute__((ext_vector_type(4)));
typedef unsigned u32x4 __attribute__((ext_vector_type(4)));
constexpr int BM = 256, BK = 64, HALF = 128, HTB = HALF * BK * 2  , STAGE_BYTES = 8 * HTB, NXCD = 8, WGM = 8;

__host__ __device__ __forceinline__ int lds_byte(int r, int c) { const int st = (r >> 4) * 2 + (c >> 5), rr = r & 15, cc = c & 31, ob = rr * 64 + cc * 2; return st * 1024 + (ob ^ (((ob >> 9) & 1) << 5)); }
__host__ __device__ __forceinline__ void stage_rc(int b, int& R, int& C) { const int st = b / 1024, sb = b % 1024, swz = sb ^ (((sb >> 9) & 1) << 5); R = (st >> 1) * 16 + swz / 64; C = (st & 1) * 32 + (swz % 64) / 2; }
__host__ __device__ __forceinline__ int perm32(int rho) { const int n = rho >> 4, i = rho & 15; return 8 * (i >> 2) + 4 * n + (i & 3); }

struct Unit { int pm, pn; };
struct Gemm { const bf16_t* A; const bf16_t* Bt; int M, N, K; };

struct StaticOrder {
    int nM, nN, nwg, G, c;
    __host__ __device__ void init(int M, int N, int G_, int c_) { nM = M / BM; nN = N / BM; nwg = nM * nN; G = G_; c = c_; }
    __host__ __device__ bool next(int i, Unit& u) const {
        const long L = (long)i * G + c; if (L >= nwg) return false;
        int wgid = (int)L; { const int q = nwg / NXCD, r = nwg % NXCD, xcd = wgid % NXCD, off = wgid / NXCD; wgid = (xcd < r ? xcd * (q + 1) : r * (q + 1) + (xcd - r) * q) + off; }
        const int nig = WGM * nN, gid = wgid / nig, fm = gid * WGM, gsz = (nM - fm) < WGM ? (nM - fm) : WGM;
        u.pm = fm + ((wgid % nig) % gsz); u.pn = (wgid % nig) / gsz; return true;
    }
    __device__ __forceinline__ void a_ready(const Unit&) const {}
    __device__ __forceinline__ void done(const Unit&) const {}
};


__device__ __forceinline__ unsigned cvt_pk_bf16(float lo, float hi) { unsigned r; asm volatile("v_cvt_pk_bf16_f32 %0, %1, %2" : "=v"(r) : "v"(lo), "v"(hi)); return r; }
__device__ __forceinline__ float sigm_fast(float x) { return __builtin_amdgcn_rcpf(1.f + __builtin_amdgcn_exp2f(-1.4426950408889634f * x)); }
__device__ __forceinline__ float gelu_f(float x) { const float z = x * (0.7978845608028654f + 0.035677408136300125f * x * x); return x * __builtin_amdgcn_rcpf(1.f + __builtin_amdgcn_exp2f(-2.885390081777927f * z)); }
typedef unsigned u32x2 __attribute__((ext_vector_type(2)));

struct EpiInProj {
    static constexpr bool PERM = true, AFTER_DRAIN = false;
    const float* bias; bf16_t* aglu; bf16_t* ug; bf16_t* vg;
    __device__ __forceinline__ void operator()(const f32x4 (&acc)[2][2][4][2], const Unit& u, int wr, int wc, int fr, int fq) const {
        const int row0 = u.pm * BM + wr * 64 + fr, cc = wc * 32 + 8 * fq;
        f32x4 bv[2][2];
#pragma unroll
        for (int bj = 0; bj < 2; ++bj)
#pragma unroll
            for (int n = 0; n < 2; ++n) bv[bj][n] = *(const f32x4*)(bias + u.pn * BM + bj * HALF + cc + 4 * n);
        if (u.pn < 4) {
            bf16_t* base = aglu + u.pn * HALF + cc;
#pragma unroll
            for (int ai = 0; ai < 2; ++ai)
#pragma unroll
                for (int m = 0; m < 4; ++m) { const size_t row = (size_t)(row0 + ai * HALF + m * 16);
                    float a[8];
#pragma unroll
                    for (int n = 0; n < 2; ++n) { const f32x4 v = acc[ai][0][m][n] + bv[0][n], g = acc[ai][1][m][n] + bv[1][n];
#pragma unroll
                        for (int j = 0; j < 4; ++j) a[4 * n + j] = v[j] * sigm_fast(g[j]); }
                    u32x4 w; w.x = cvt_pk_bf16(a[0], a[1]); w.y = cvt_pk_bf16(a[2], a[3]); w.z = cvt_pk_bf16(a[4], a[5]); w.w = cvt_pk_bf16(a[6], a[7]);
                    *(u32x4*)(base + row * 512) = w; }
        } else {
            const int off = (u.pn - 4) * HALF + cc;
#pragma unroll
            for (int ai = 0; ai < 2; ++ai)
#pragma unroll
                for (int m = 0; m < 4; ++m) { const size_t row = (size_t)(row0 + ai * HALF + m * 16);
#pragma unroll
                    for (int bj = 0; bj < 2; ++bj) { float a[8];
#pragma unroll
                        for (int n = 0; n < 2; ++n) { const f32x4 v = acc[ai][bj][m][n] + bv[bj][n];
#pragma unroll
                            for (int j = 0; j < 4; ++j) a[4 * n + j] = gelu_f(v[j]); }
                        u32x4 w; w.x = cvt_pk_bf16(a[0], a[1]); w.y = cvt_pk_bf16(a[2], a[3]); w.z = cvt_pk_bf16(a[4], a[5]); w.w = cvt_pk_bf16(a[6], a[7]);
                        *(u32x4*)((bj == 0 ? ug : vg) + row * 512 + off) = w; } }
        }
    }
};

struct EpiOutProj {
    static constexpr bool PERM = true, AFTER_DRAIN = false;
    const float* x; const float* b_out; const float* cond; const float* g2; bf16_t* x1; bf16_t* xg; float* part;
    __device__ __forceinline__ void operator()(const f32x4 (&acc)[2][2][4][2], const Unit& u, int wr, int wc, int fr, int fq) const {
        const int row0 = u.pm * BM + wr * 64 + fr, col0 = u.pn * BM + wc * 32 + 8 * fq, b = (u.pm * BM) >> 13;
        const float* cb = cond + b * 6144;
        float ssq[2][4];
#pragma unroll
        for (int ai = 0; ai < 2; ++ai)
#pragma unroll
            for (int m = 0; m < 4; ++m) ssq[ai][m] = 0.f;
#pragma unroll
        for (int bj = 0; bj < 2; ++bj) { const int col = col0 + bj * HALF;
            f32x4 bo[2], gt[2], gg[2];
#pragma unroll
            for (int n = 0; n < 2; ++n) { bo[n] = *(const f32x4*)(b_out + col + 4 * n); gt[n] = *(const f32x4*)(cb + 2048 + col + 4 * n); gg[n] = *(const f32x4*)(g2 + col + 4 * n) * (*(const f32x4*)(cb + 4096 + col + 4 * n) + 1.0f); }
#pragma unroll
            for (int am = 0; am < 4; ++am) { const int ai = am >> 1;
                f32x4 xl[4][2];
#pragma unroll
                for (int m = 2 * (am & 1); m < 2 * (am & 1) + 2; ++m)
#pragma unroll
                    for (int n = 0; n < 2; ++n) xl[m][n] = *(const f32x4*)(x + (size_t)(row0 + ai * HALF + m * 16) * 1024 + col + 4 * n);
                __builtin_amdgcn_sched_barrier(0);
#pragma unroll
                for (int m = 2 * (am & 1); m < 2 * (am & 1) + 2; ++m) { const size_t off = (size_t)(row0 + ai * HALF + m * 16) * 1024 + col;
                    const f32x4 r0 = xl[m][0] + gt[0] * (acc[ai][bj][m][0] + bo[0]), r1 = xl[m][1] + gt[1] * (acc[ai][bj][m][1] + bo[1]);
                    { u32x4 wx; wx.x = cvt_pk_bf16(r0[0], r0[1]); wx.y = cvt_pk_bf16(r0[2], r0[3]); wx.z = cvt_pk_bf16(r1[0], r1[1]); wx.w = cvt_pk_bf16(r1[2], r1[3]); *(u32x4*)(x1 + off) = wx; }
                    ssq[ai][m] += ((r0[0] * r0[0] + r0[1] * r0[1]) + (r0[2] * r0[2] + r0[3] * r0[3])) + ((r1[0] * r1[0] + r1[1] * r1[1]) + (r1[2] * r1[2] + r1[3] * r1[3]));
                    const f32x4 h0 = r0 * gg[0], h1 = r1 * gg[1]; u32x4 w; w.x = cvt_pk_bf16(h0[0], h0[1]); w.y = cvt_pk_bf16(h0[2], h0[3]); w.z = cvt_pk_bf16(h1[0], h1[1]); w.w = cvt_pk_bf16(h1[2], h1[3]);
                    *(u32x4*)(xg + off) = w; } } }
#pragma unroll
        for (int ai = 0; ai < 2; ++ai)
#pragma unroll
            for (int m = 0; m < 4; ++m) { float s = ssq[ai][m]; s += __shfl_xor(s, 16); s += __shfl_xor(s, 32);
                if (fq == 0) part[(size_t)(row0 + ai * HALF + m * 16) * 16 + u.pn * 4 + wc] = s; }
    }
};

struct EpiQuery {
    static constexpr bool PERM = true, AFTER_DRAIN = false;
    const float* part; const float* qb; bf16_t* q;
    __device__ __forceinline__ void operator()(const f32x4 (&acc)[2][2][4][2], const Unit& u, int wr, int wc, int fr, int fq) const {
        const int row0 = u.pm * BM + wr * 64 + fr, col0 = u.pn * BM + wc * 32 + 8 * fq, b = (u.pm * BM) >> 13;
        f32x4 qv[2][2];
#pragma unroll
        for (int bj = 0; bj < 2; ++bj)
#pragma unroll
            for (int n = 0; n < 2; ++n) qv[bj][n] = *(const f32x4*)(qb + b * 2048 + col0 + bj * HALF + 4 * n);
#pragma unroll
        for (int ai = 0; ai < 2; ++ai) {
            f32x4 pl[4];
#pragma unroll
            for (int m = 0; m < 4; ++m) pl[m] = *(const f32x4*)(part + (size_t)(row0 + ai * HALF + m * 16) * 16 + 4 * fq);
            __builtin_amdgcn_sched_barrier(0);
#pragma unroll
            for (int m = 0; m < 4; ++m) { const size_t row = (size_t)(row0 + ai * HALF + m * 16);
                const f32x4 p4 = pl[m];
                float s = (p4[0] + p4[1]) + (p4[2] + p4[3]); s += __shfl_xor(s, 16); s += __shfl_xor(s, 32);
                const float r = rsqrtf(s * (1.f / 1024.f) + 1e-6f);
#pragma unroll
                for (int bj = 0; bj < 2; ++bj) { const f32x4 v0 = acc[ai][bj][m][0] * r + qv[bj][0], v1 = acc[ai][bj][m][1] * r + qv[bj][1];
                    u32x4 w; w.x = cvt_pk_bf16(v0[0], v0[1]); w.y = cvt_pk_bf16(v0[2], v0[3]); w.z = cvt_pk_bf16(v1[0], v1[1]); w.w = cvt_pk_bf16(v1[2], v1[3]);
                    *(u32x4*)(q + row * 2048 + col0 + bj * HALF) = w; } } }
    }
};
template <class Epi, class Sched, bool ALIGN_EPI = false, bool SP2 = false>
__device__ __forceinline__ void gemm_phase(PG8_LAS unsigned char* lds, const Gemm g, const Sched& S, const Epi& E) {
    const int tid = phase_tid(), wid = __builtin_amdgcn_readfirstlane(tid >> 6), lane = tid & 63, wr = wid >> 2, wc = wid & 3, fr = lane & 15, fq = lane >> 4;
    const int K = g.K, nt = K / BK;
    unsigned voffA[2], voffB[2];
#pragma unroll
    for (int i = 0; i < 2; ++i) { int R, C; stage_rc(tid * 16 + i * 8192, R, C); const int Rb = Epi::PERM ? ((R & ~31) + perm32(R & 31)) : R;
        voffA[i] = (unsigned)(R * K + C) * 2u; voffB[i] = (unsigned)(Rb * K + C) * 2u; }
    const size_t kstep = (size_t)(BK * 2);
    const size_t hstep = (size_t)HALF * K * 2;
    const size_t tstep = 2 * hstep;
    const unsigned ldsw = (unsigned)wid * 1024u;
    const int aoff = lds_byte(wr * 64 + fr, fq * 8), boff = lds_byte(wc * 32 + fr, fq * 8);
#define PG8_SA(b, h) (((b) * 2 + (h)) * HTB)
#define PG8_SB(b, h) ((4 + (b) * 2 + (h)) * HTB)
#define PG8_STAGE(bufoff, gbase, voff) do { _Pragma("unroll") for (int _i = 0; _i < 2; ++_i) \
        __builtin_amdgcn_global_load_lds((const unsigned*)((const char*)(gbase) + (voff)[_i]), (PG8_LAS unsigned*)(lds + (bufoff) + ldsw + _i * 8192), 16, 0, 0); } while (0)
#define PG8_LDA(dst, b, h) do { _Pragma("unroll") for (int m = 0; m < 4; ++m) _Pragma("unroll") for (int k = 0; k < 2; ++k) dst[m][k] = *(const PG8_LAS bf16x8*)(lds + PG8_SA(b, h) + aoff + m * 2048 + k * 1024); } while (0)
#define PG8_LDB(dst, b, h) do { _Pragma("unroll") for (int n = 0; n < 2; ++n) _Pragma("unroll") for (int k = 0; k < 2; ++k) dst[n][k] = *(const PG8_LAS bf16x8*)(lds + PG8_SB(b, h) + boff + n * 2048 + k * 1024); } while (0)
#define PG8_MMA(ai, bj, At, Bt) do { __builtin_amdgcn_s_setprio(1); _Pragma("unroll") for (int m = 0; m < 4; ++m) _Pragma("unroll") for (int n = 0; n < 2; ++n) _Pragma("unroll") for (int k = 0; k < 2; ++k) \
        acc[ai][bj][m][n] = __builtin_amdgcn_mfma_f32_16x16x32_bf16(Bt[n][k], At[m][k], acc[ai][bj][m][n], 0, 0, 0); __builtin_amdgcn_s_setprio(0); } while (0)
#define PG8_WAIT_V(n) asm volatile("s_waitcnt vmcnt(" #n ")" ::: "memory")
#define PG8_WAIT_L(n) asm volatile("s_waitcnt lgkmcnt(" #n ")" ::: "memory")
#define PG8_BAR __builtin_amdgcn_s_barrier()
#define PG8_SCHED __builtin_amdgcn_sched_barrier(0)
    Unit cur, nxt; int ui = 0;
    if (!S.next(0, cur)) return;
    f32x4 acc[2][2][4][2];
#pragma unroll
    for (int a = 0; a < 2; ++a)
#pragma unroll
        for (int b = 0; b < 2; ++b)
#pragma unroll
            for (int m = 0; m < 4; ++m)
#pragma unroll
                for (int n = 0; n < 2; ++n) acc[a][b][m][n] = (f32x4){0.f, 0.f, 0.f, 0.f};
    bf16x8 At[4][2], B0[2][2], B1[2][2];
    const char* cA = (const char*)g.A + (size_t)cur.pm * tstep; const char* cB = (const char*)g.Bt + (size_t)cur.pn * tstep;
    S.a_ready(cur);
    if constexpr (SP2) {
        PG8_STAGE(PG8_SB(0, 0), cB, voffB); PG8_STAGE(PG8_SB(0, 1), cB + hstep, voffB); PG8_STAGE(PG8_SA(0, 0), cA, voffA); PG8_STAGE(PG8_SA(0, 1), cA + hstep, voffA);
        if (wr == 1) PG8_BAR;
        PG8_WAIT_V(2); PG8_BAR;
        PG8_STAGE(PG8_SB(1, 0), cB + kstep, voffB); PG8_STAGE(PG8_SA(1, 0), cA + kstep, voffA); PG8_STAGE(PG8_SB(1, 1), cB + hstep + kstep, voffB);
        PG8_WAIT_V(6); PG8_BAR;
    } else {
        PG8_STAGE(PG8_SB(0, 0), cB, voffB); PG8_STAGE(PG8_SA(0, 0), cA, voffA); PG8_STAGE(PG8_SB(0, 1), cB + hstep, voffB); PG8_STAGE(PG8_SA(0, 1), cA + hstep, voffA);
        if (wr == 1) PG8_BAR;
        PG8_WAIT_V(4); PG8_BAR;
        PG8_STAGE(PG8_SB(1, 0), cB + kstep, voffB); PG8_STAGE(PG8_SA(1, 0), cA + kstep, voffA); PG8_STAGE(PG8_SB(1, 1), cB + hstep + kstep, voffB);
        PG8_WAIT_V(6); PG8_BAR;
    }
    for (;;) {
        const bool has_next = S.next(ui + 1, nxt);
        const char* nA = has_next ? (const char*)g.A + (size_t)nxt.pm * tstep : cA; const char* nB = has_next ? (const char*)g.Bt + (size_t)nxt.pn * tstep : cB;
        for (int t = 0; t < nt; t += 2) {
            const bool last = (t == nt - 2);
            const char* a1 = cA + (size_t)(t + 1) * kstep;
            const char* a2 = last ? nA : cA + (size_t)(t + 2) * kstep; const char* b2 = last ? nB : cB + (size_t)(t + 2) * kstep;
            const char* a3 = a2 + kstep; const char* b3 = b2 + kstep;
            if (last && has_next) S.a_ready(nxt);
            if constexpr (SP2) {
            PG8_LDB(B0, 0, 0); PG8_LDB(B1, 0, 1); PG8_SCHED; PG8_LDA(At, 0, 0); PG8_STAGE(PG8_SA(1, 1), a1 + hstep, voffA);
            PG8_WAIT_V(8); PG8_WAIT_L(0); PG8_BAR; PG8_MMA(0, 0, At, B0); PG8_MMA(0, 1, At, B1); PG8_BAR; PG8_SCHED;
            PG8_LDA(At, 0, 1); PG8_STAGE(PG8_SB(0, 0), b2, voffB); PG8_STAGE(PG8_SB(0, 1), b2 + hstep, voffB); PG8_STAGE(PG8_SA(0, 0), a2, voffA);
            PG8_WAIT_V(8); PG8_WAIT_L(0); PG8_BAR; PG8_MMA(1, 0, At, B0); PG8_MMA(1, 1, At, B1); PG8_BAR; PG8_SCHED;
            PG8_LDB(B0, 1, 0); PG8_LDB(B1, 1, 1); PG8_SCHED; PG8_LDA(At, 1, 0); PG8_STAGE(PG8_SA(0, 1), a2 + hstep, voffA);
            PG8_WAIT_V(8); PG8_WAIT_L(0); PG8_BAR; PG8_MMA(0, 0, At, B0); PG8_MMA(0, 1, At, B1); PG8_BAR; PG8_SCHED;
            PG8_LDA(At, 1, 1); PG8_STAGE(PG8_SB(1, 0), b3, voffB); PG8_STAGE(PG8_SB(1, 1), b3 + hstep, voffB); PG8_STAGE(PG8_SA(1, 0), a3, voffA);
            PG8_WAIT_V(8); PG8_WAIT_L(0); PG8_BAR; PG8_MMA(1, 0, At, B0); PG8_MMA(1, 1, At, B1); PG8_BAR; PG8_SCHED;
            } else {
            PG8_LDB(B0, 0, 0); PG8_SCHED; PG8_LDA(At, 0, 0); PG8_STAGE(PG8_SA(1, 1), a1 + hstep, voffA);
            PG8_WAIT_L(8); PG8_BAR; PG8_WAIT_L(0); PG8_MMA(0, 0, At, B0); PG8_BAR; PG8_SCHED;
            PG8_LDB(B1, 0, 1); PG8_STAGE(PG8_SB(0, 0), b2, voffB);
            PG8_BAR; PG8_WAIT_L(0); PG8_MMA(0, 1, At, B1); PG8_BAR;
            PG8_LDA(At, 0, 1); PG8_STAGE(PG8_SA(0, 0), a2, voffA);
            PG8_BAR; PG8_WAIT_L(0); PG8_MMA(1, 0, At, B0); PG8_BAR; PG8_SCHED;
            PG8_STAGE(PG8_SB(0, 1), b2 + hstep, voffB);
            PG8_WAIT_V(6); PG8_BAR; PG8_MMA(1, 1, At, B1); PG8_BAR;
            PG8_LDB(B0, 1, 0); PG8_SCHED; PG8_LDA(At, 1, 0); PG8_STAGE(PG8_SA(0, 1), a2 + hstep, voffA);
            PG8_WAIT_L(8); PG8_BAR; PG8_WAIT_L(0); PG8_MMA(0, 0, At, B0); PG8_BAR; PG8_SCHED;
            PG8_LDB(B1, 1, 1); PG8_STAGE(PG8_SB(1, 0), b3, voffB);
            PG8_BAR; PG8_WAIT_L(0); PG8_MMA(0, 1, At, B1); PG8_BAR;
            PG8_LDA(At, 1, 1); PG8_STAGE(PG8_SA(1, 0), a3, voffA);
            PG8_BAR; PG8_WAIT_L(0); PG8_MMA(1, 0, At, B0); PG8_BAR; PG8_SCHED;
            PG8_STAGE(PG8_SB(1, 1), b3 + hstep, voffB);
            PG8_WAIT_V(6); PG8_BAR; PG8_MMA(1, 1, At, B1); PG8_BAR;
            }
        }
        if constexpr (ALIGN_EPI) { if (wr == 0) PG8_BAR; }
        if constexpr (!Epi::AFTER_DRAIN) { E(acc, cur, wr, wc, fr, fq); S.done(cur); }
        if (!has_next) break;
#pragma unroll
        for (int a = 0; a < 2; ++a)
#pragma unroll
            for (int b = 0; b < 2; ++b)
#pragma unroll
                for (int m = 0; m < 4; ++m)
#pragma unroll
                    for (int n = 0; n < 2; ++n) acc[a][b][m][n] = (f32x4){0.f, 0.f, 0.f, 0.f};
        cur = nxt; cA = nA; cB = nB; ++ui;
        if constexpr (ALIGN_EPI) { if (wr == 1) PG8_BAR; }
    }
    PG8_WAIT_V(0);
    if constexpr (!ALIGN_EPI) { if (wr == 0) PG8_BAR; }
    PG8_BAR;
    if constexpr (Epi::AFTER_DRAIN) { E.fused(acc, cur, wr, wc, fr, fq, lds, wid, lane); S.done(cur); }
#undef PG8_SA
#undef PG8_SB
#undef PG8_STAGE
#undef PG8_LDA
#undef PG8_LDB
#undef PG8_MMA
#undef PG8_WAIT_V
#undef PG8_WAIT_L
#undef PG8_BAR
#undef PG8_SCHED
}
}
#define LAS __attribute__((address_space(3)))
typedef unsigned short bf16_t;
typedef short bf16x8 __attribute__((ext_vector_type(8)));
typedef float f32x4 __attribute__((ext_vector_type(4)));
typedef unsigned u32x4 __attribute__((ext_vector_type(4)));
typedef unsigned u32x2 __attribute__((ext_vector_type(2)));
constexpr size_t MiB = 1u << 20;
constexpr size_t WS_CTL = 0, WS_COND = 1 * MiB, WS_QB = 1 * MiB + 65536, WS_BIAS1 = 1 * MiB + 98304, WS_PART = 2 * MiB;
constexpr size_t WS_BT1 = 4 * MiB, WS_BT2 = 8 * MiB, WS_BT3 = 10 * MiB, WS_KEYS = 14 * MiB, WS_WSB = 14 * MiB + 524288;
constexpr size_t WS_UFP8 = 16 * MiB, WS_VFP8 = 32 * MiB, WS_HB = 48 * MiB  , WS_YCAT = 80 * MiB, WS_AGLU = 112 * MiB, WS_UG = 128 * MiB, WS_VG = 144 * MiB;
constexpr size_t WS_X1B = 112 * MiB;
constexpr size_t WS_Q = 160 * MiB, WS_EIDX = 240 * MiB, WS_GATE = 248 * MiB;

struct Params {
    const float* in[23];
    float* out;
    unsigned char* ws;
};
enum { I_X = 0, I_C, I_WADA, I_BADA, I_G1, I_WIN, I_BIN, I_CONVW, I_CONVB, I_GCLN, I_BCLN, I_GVLN, I_BVLN, I_WSP, I_BSP, I_WOUT, I_BOUT, I_G2, I_WQ, I_KEYS, I_EU, I_EV, I_GF };

__device__ __forceinline__ unsigned pk_bf16(float lo, float hi) { unsigned r; asm volatile("v_cvt_pk_bf16_f32 %0, %1, %2" : "=v"(r) : "v"(lo), "v"(hi)); return r; }
__device__ __forceinline__ float bf_lo(unsigned w) { return __uint_as_float(w << 16); }
__device__ __forceinline__ float bf_hi(unsigned w) { return __uint_as_float(w & 0xffff0000u); }

typedef float f32x16 __attribute__((ext_vector_type(16)));
typedef float f32x32 __attribute__((ext_vector_type(32)));
typedef unsigned u32x6 __attribute__((ext_vector_type(6)));
#ifndef FMT_U
#define FMT_U 4
#endif
#ifndef FMT_V
#define FMT_V 4
#endif
template <int FMT> struct RowFmt { static constexpr int LB = FMT == 6 ? 24 : 16, RSB = FMT == 6 ? 768 : 512; };
constexpr size_t WS_SU = 1 * MiB + 262144, WS_SV = 1 * MiB + 262144 + 65536;
constexpr size_t WS_USC = 24 * MiB, WS_VSC = 40 * MiB;
__device__ __forceinline__ float half_max(float v) {
    v = fmaxf(v, SWZ(v, 0x401F)); v = fmaxf(v, SWZ(v, 0x201F)); v = fmaxf(v, SWZ(v, 0x101F)); v = fmaxf(v, SWZ(v, 0x081F)); v = fmaxf(v, SWZ(v, 0x041F)); return v;
}
template <int FMT> __device__ __forceinline__ void convert_row_from(const float4 (&xl)[8], unsigned char* __restrict__ dst, float* __restrict__ side, int l32);
template <int FMT> __device__ __forceinline__ void convert_row(const float* __restrict__ src, unsigned char* __restrict__ dst, float* __restrict__ side, int l32) {
    float4 xl[8];
#pragma unroll
    for (int j = 0; j < 8; ++j) xl[j] = *(const float4*)(src + 128 * j + 4 * l32);
    __builtin_amdgcn_sched_barrier(0);
    convert_row_from<FMT>(xl, dst, side, l32);
}
template <int FMT> __device__ __forceinline__ void convert_row_from(const float4 (&xl)[8], unsigned char* __restrict__ dst, float* __restrict__ side, int l32) {
    float v[32]; float am = 0.f;
#pragma unroll
    for (int j = 0; j < 8; ++j) { const float4 x = xl[j]; v[4 * j] = x.x; v[4 * j + 1] = x.y; v[4 * j + 2] = x.z; v[4 * j + 3] = x.w;
        am = fmaxf(am, fmaxf(fmaxf(fabsf(x.x), fabsf(x.y)), fmaxf(fabsf(x.z), fabsf(x.w)))); }
    if constexpr (FMT == 6) {
        am = half_max(am);
        const float s = fmaxf(am, 1e-30f) * (1.f / 7.5f), inv = 1.f / s;
        f32x16 a, b;
#pragma unroll
        for (int m = 0; m < 16; ++m) { a[m] = v[m] * inv; b[m] = v[16 + m] * inv; }
        const u32x6 w = __builtin_amdgcn_cvt_scalef32_2xpk16_fp6_f32(a, b, 1.0f);
        u32x4 w0; w0.x = w[0]; w0.y = w[1]; w0.z = w[2]; w0.w = w[3]; u32x2 w1; w1.x = w[4]; w1.y = w[5];
        *(u32x4*)(dst + 24 * l32) = w0; *(u32x2*)(dst + 24 * l32 + 16) = w1;
        if (l32 == 0) *side = s;
    } else {
        const unsigned sb = pk_bf16(fmaxf(am, 1e-30f) * (1.f / 6.f), 0.f) & 0xffffu;
        const float s = __uint_as_float(sb << 16), inv = 1.f / s;
        u32x4 w; unsigned* wp = (unsigned*)&w;
#pragma unroll
        for (int d = 0; d < 4; ++d) { unsigned x = 0u;
            x = __builtin_amdgcn_cvt_scalef32_pk_fp4_f32(x, v[8 * d + 0] * inv, v[8 * d + 1] * inv, 1.0f, 0);
            x = __builtin_amdgcn_cvt_scalef32_pk_fp4_f32(x, v[8 * d + 2] * inv, v[8 * d + 3] * inv, 1.0f, 1);
            x = __builtin_amdgcn_cvt_scalef32_pk_fp4_f32(x, v[8 * d + 4] * inv, v[8 * d + 5] * inv, 1.0f, 2);
            x = __builtin_amdgcn_cvt_scalef32_pk_fp4_f32(x, v[8 * d + 6] * inv, v[8 * d + 7] * inv, 1.0f, 3);
            wp[d] = x; }
        *(u32x4*)(dst + 16 * l32) = w;
        ((unsigned short*)side)[l32] = (unsigned short)sb;
    }
}
template <int FMT> struct RowData;
template <> struct RowData<6> { u32x4 a; u32x2 b; };
template <> struct RowData<4> { u32x4 a; unsigned short sc; };
template <int FMT> __device__ __forceinline__ RowData<FMT> row_load(const unsigned char* p  , const unsigned char* psc  ) {
    RowData<FMT> r;
    if constexpr (FMT == 6) { r.a = *(const u32x4*)p; r.b = *(const u32x2*)(p + 16); }
    else { r.a = *(const u32x4*)p; r.sc = *(const unsigned short*)psc; }
    return r;
}
template <int FMT> __device__ __forceinline__ void row_decode(const RowData<FMT>& r, f32x2 (&o)[16], float& bscale) {
    if constexpr (FMT == 6) {
        u32x6 w; w[0] = r.a.x; w[1] = r.a.y; w[2] = r.a.z; w[3] = r.a.w; w[4] = r.b.x; w[5] = r.b.y;
        const f32x32 f = __builtin_amdgcn_cvt_scalef32_pk32_f32_fp6(w, 1.0f);
#pragma unroll
        for (int m = 0; m < 16; ++m) o[m] = (f32x2){f[2 * m], f[2 * m + 1]};
        bscale = 1.f;
    } else {
        const unsigned* wp = (const unsigned*)&r.a;
#pragma unroll
        for (int d = 0; d < 4; ++d) { o[4 * d + 0] = __builtin_amdgcn_cvt_scalef32_pk_f32_fp4(wp[d], 1.0f, 0); o[4 * d + 1] = __builtin_amdgcn_cvt_scalef32_pk_f32_fp4(wp[d], 1.0f, 1);
            o[4 * d + 2] = __builtin_amdgcn_cvt_scalef32_pk_f32_fp4(wp[d], 1.0f, 2); o[4 * d + 3] = __builtin_amdgcn_cvt_scalef32_pk_f32_fp4(wp[d], 1.0f, 3); }
        bscale = __uint_as_float((unsigned)r.sc << 16);
    }
}
__device__ __forceinline__ float reduce8_half(const float (&s)[8], int lane) {
    const bool b4 = lane & 16, b3 = lane & 8, b2 = lane & 4;
    float u[4];
#pragma unroll
    for (int k = 0; k < 4; ++k) { const float keep = b4 ? s[k + 4] : s[k], send = b4 ? s[k] : s[k + 4]; u[k] = keep + SWZ(send, 0x401F); }
    float v[2];
#pragma unroll
    for (int k = 0; k < 2; ++k) { const float keep = b3 ? u[k + 2] : u[k], send = b3 ? u[k] : u[k + 2]; v[k] = keep + SWZ(send, 0x201F); }
    const float keep = b2 ? v[1] : v[0], send = b2 ? v[0] : v[1];
    float w = keep + SWZ(send, 0x101F);
    w += SWZ(w, 0x081F); w += SWZ(w, 0x041F);
    return w;
}
typedef int i32x8 __attribute__((ext_vector_type(8)));
typedef _Float16 h16x2 __attribute__((ext_vector_type(2)));
__device__ __forceinline__ void convert_row_umx_from(const float4 (&xl)[8], unsigned char* __restrict__ dst, unsigned char* __restrict__ sdst, int l32);
__device__ __forceinline__ void convert_row_umx(const float* __restrict__ src, unsigned char* __restrict__ dst, unsigned char* __restrict__ sdst, int l32) {
    float4 xl[8];
#pragma unroll
    for (int j = 0; j < 8; ++j) xl[j] = *(const float4*)(src + 32 * l32 + 4 * j);
    __builtin_amdgcn_sched_barrier(0);
    convert_row_umx_from(xl, dst, sdst, l32);
}
__device__ __forceinline__ void convert_row_umx_from(const float4 (&xl)[8], unsigned char* __restrict__ dst, unsigned char* __restrict__ sdst, int l32) {
    float v[32]; float am = 0.f;
#pragma unroll
    for (int j = 0; j < 8; ++j) { v[4 * j] = xl[j].x; v[4 * j + 1] = xl[j].y; v[4 * j + 2] = xl[j].z; v[4 * j + 3] = xl[j].w;
        am = fmaxf(am, fmaxf(fmaxf(fabsf(xl[j].x), fabsf(xl[j].y)), fmaxf(fabsf(xl[j].z), fabsf(xl[j].w)))); }
    am = fmaxf(am, 1e-30f);
    const int bits = __float_as_int(am * (1.f / 6.f));
    const int e_up = ((bits >> 23) & 255) - 127 + ((bits & 0x7fffff) ? 1 : 0);
    const float s_dn = __int_as_float((e_up - 1 + 127) << 23);
    int e = (am <= 7.f * s_dn) ? e_up - 1 : e_up;
    e = e < -120 ? -120 : (e > 120 ? 120 : e);
    const float inv = __int_as_float((127 - e) << 23);
    u32x4 w; unsigned* wp = (unsigned*)&w;
#pragma unroll
    for (int d = 0; d < 4; ++d) { unsigned x = 0u;
        x = __builtin_amdgcn_cvt_scalef32_pk_fp4_f32(x, v[8 * d + 0] * inv, v[8 * d + 1] * inv, 1.0f, 0);
        x = __builtin_amdgcn_cvt_scalef32_pk_fp4_f32(x, v[8 * d + 2] * inv, v[8 * d + 3] * inv, 1.0f, 1);
        x = __builtin_amdgcn_cvt_scalef32_pk_fp4_f32(x, v[8 * d + 4] * inv, v[8 * d + 5] * inv, 1.0f, 2);
        x = __builtin_amdgcn_cvt_scalef32_pk_fp4_f32(x, v[8 * d + 6] * inv, v[8 * d + 7] * inv, 1.0f, 3);
        wp[d] = x; }
    *(u32x4*)(dst + 16 * l32) = w;
    sdst[8 * (l32 & 3) + (l32 >> 2)] = (unsigned char)(e + 127);
}
constexpr int PEER_LDS_TAB = 7168 * 4;
constexpr int PEER_HS = 2080 + 4096;
template <int PMODE> __device__ __forceinline__ void phase_peer(const Params& P, float* ldsf, int bid, int nblk, float* xout) {
    constexpr int LBV = RowFmt<FMT_V>::LB, RSV = RowFmt<FMT_V>::RSB, RSU = 512;
    const unsigned char* usct = P.ws + WS_USC; const unsigned char* vsct = P.ws + WS_VSC;
    const float* cond = (const float*)(P.ws + WS_COND); const float* part = (const float*)(P.ws + WS_PART);
    const int* eidx = (const int*)(P.ws + WS_EIDX); const float* gate = (const float*)(P.ws + WS_GATE);
    const unsigned char* utab = P.ws + WS_UFP8; const unsigned char* vtab = P.ws + WS_VFP8;
    float* xio = P.out;
    const int tid = phase_tid(), lane = tid & 63, wave = tid >> 6, l32 = lane & 31, hf = lane >> 5, li = lane & 15, lg = lane >> 4;
    float* G2 = ldsf; float* SH2 = ldsf + 2048; float* GT2 = ldsf + 4096; float* GF = ldsf + 6144;
    LAS unsigned char* hs = (LAS unsigned char*)ldsf + PEER_LDS_TAB + wave * PEER_HS;
    for (int i = tid; i < 2048; i += 512) { const int b = i >> 10, d = i & 1023;
        G2[i] = P.in[I_G2][d] * (1.f + cond[b * 6 * D + 4 * D + d]); SH2[i] = cond[b * 6 * D + 3 * D + d]; GT2[i] = cond[b * 6 * D + 5 * D + d]; }
    for (int i = tid; i < 1024; i += 512) GF[i] = P.in[I_GF][i];
    if (lane < 8) *(LAS unsigned*)(hs + 2048 + 4 * lane) = 0u;
    __syncthreads();
    const int hb_base = li < 2 ? (li * 1024 + 16 * lg) : 2048, hb_step = li < 2 ? 128 : 0, hb_hi = li < 2 ? 64 : 16;
    const int sbv = 127;
    u32x4 ub[8]; u32x2 usc; RowData<FMT_V> vb[2][8];
    int t = bid * 8 + wave;
    int eA = 0, eB = 0; float gA = 0.f, gB = 0.f;
    if (t < T) { eA = eidx[(size_t)t * 128 + lane]; eB = eidx[(size_t)t * 128 + 64 + lane]; gA = gate[(size_t)t * 128 + lane]; gB = gate[(size_t)t * 128 + 64 + lane]; }
#define PEER_ISSUE_U(eS_, gg) do { const int el_ = __builtin_amdgcn_ds_bpermute(((((gg) & 3) << 4) + li) << 2, eS_); \
            const unsigned char* rb_ = utab + (size_t)el_ * RSU; \
            _Pragma("unroll") for (int c = 0; c < 8; ++c) ub[c] = *(const u32x4*)(rb_ + 16 * lg + 64 * c); usc = *(const u32x2*)(usct + (size_t)el_ * 32 + 8 * lg); } while (0)
#define PEER_ISSUE_V1(bf, eS_, gg, p) do { const int l0_ = ((gg) & 3) << 4; \
            const int e0_ = __builtin_amdgcn_readlane(eS_, l0_ + 2 * (p)), e1_ = __builtin_amdgcn_readlane(eS_, l0_ + 2 * (p) + 1); \
            const int ev_ = hf ? e1_ : e0_; vb[bf][p] = row_load<FMT_V>(vtab + (size_t)ev_ * RSV + LBV * l32, vsct + (size_t)ev_ * 64 + 2 * l32); } while (0)
    if (t < T) {
        PEER_ISSUE_U(eA, 0);
#pragma unroll
        for (int p = 0; p < 8; ++p) PEER_ISSUE_V1(0, eA, 0, p);
#pragma unroll
        for (int p = 0; p < 8; ++p) PEER_ISSUE_V1(1, eA, 1, p); }
    for (; t < T; t += nblk * 8) {
        const int b = t >> 13;
        const bf16_t* xrow = (const bf16_t*)(P.ws + WS_X1B) + (size_t)t * D;
        const int tn = (t + nblk * 8 < T) ? t + nblk * 8 : t;
        const int eAn = __builtin_nontemporal_load(eidx + (size_t)tn * 128 + lane), eBn = __builtin_nontemporal_load(eidx + (size_t)tn * 128 + 64 + lane); const float gAn = __builtin_nontemporal_load(gate + (size_t)tn * 128 + lane), gBn = __builtin_nontemporal_load(gate + (size_t)tn * 128 + 64 + lane);
        const float4* pp = (const float4*)(part + (size_t)t * 16);
        const float4 q0 = pp[0], q1 = pp[1], q2 = pp[2], q3 = pp[3];
        float4 xl[4];
#pragma unroll
        for (int j = 0; j < 2; ++j) { const u32x4 xv_ = __builtin_nontemporal_load((const u32x4*)(xrow + 16 * lane + 8 * j));
            xl[2 * j].x = bf_lo(xv_.x); xl[2 * j].y = bf_hi(xv_.x); xl[2 * j].z = bf_lo(xv_.y); xl[2 * j].w = bf_hi(xv_.y); xl[2 * j + 1].x = bf_lo(xv_.z); xl[2 * j + 1].y = bf_hi(xv_.z); xl[2 * j + 1].z = bf_lo(xv_.w); xl[2 * j + 1].w = bf_hi(xv_.w); }
        __builtin_amdgcn_sched_barrier(0);
        const float ss = (((q0.x + q0.y) + (q0.z + q0.w)) + ((q1.x + q1.y) + (q1.z + q1.w))) + (((q2.x + q2.y) + (q2.z + q2.w)) + ((q3.x + q3.y) + (q3.z + q3.w)));
        const float r = rsqrtf(ss * (1.f / D) + EPS);
        {
            u32x4 whi, wlo; unsigned* ph = (unsigned*)&whi; unsigned* pl = (unsigned*)&wlo;
#pragma unroll
            for (int j = 0; j < 4; ++j) { const float4 g4 = *(const float4*)(G2 + b * 1024 + 16 * lane + 4 * j), s4 = *(const float4*)(SH2 + b * 1024 + 16 * lane + 4 * j);
                const float h0 = xl[j].x * r * g4.x + s4.x, h1 = xl[j].y * r * g4.y + s4.y, h2v = xl[j].z * r * g4.z + s4.z, h3 = xl[j].w * r * g4.w + s4.w;
                int wh = 0; wh = __builtin_amdgcn_cvt_pk_fp8_f32(h0, h1, wh, false); wh = __builtin_amdgcn_cvt_pk_fp8_f32(h2v, h3, wh, true);
                const f32x2 d01 = __builtin_amdgcn_cvt_pk_f32_fp8(wh, false), d23 = __builtin_amdgcn_cvt_pk_f32_fp8(wh, true);
                int wl = 0; wl = __builtin_amdgcn_cvt_pk_fp8_f32((h0 - d01.x), (h1 - d01.y), wl, false); wl = __builtin_amdgcn_cvt_pk_fp8_f32((h2v - d23.x), (h3 - d23.y), wl, true);
                ph[j] = (unsigned)wh; pl[j] = (unsigned)wl; }
            *(LAS u32x4*)(hs + 16 * lane) = whi; *(LAS u32x4*)(hs + 1024 + 16 * lane) = wlo;
#pragma unroll
            for (int j = 0; j < 4; ++j) *(LAS f32x4*)(hs + 2080 + 4 * (16 * lane + 4 * j)) = (f32x4){xl[j].x, xl[j].y, xl[j].z, xl[j].w};
        }
        asm volatile("s_waitcnt lgkmcnt(0)" ::: "memory");
        h16x2 o[16];
#pragma unroll
        for (int m = 0; m < 16; ++m) o[m] = (h16x2){(_Float16)0.f, (_Float16)0.f};
#pragma unroll
        for (int g = 0; g < 8; ++g) {
            constexpr int dummy_ = 0; (void)dummy_;
            const int bf = g & 1;
            f32x4 acc = {0.f, 0.f, 0.f, 0.f};
#pragma unroll
            for (int hh = 0; hh < 2; ++hh) {
                i32x8 hB[4];
#pragma unroll
                for (int c4 = 0; c4 < 4; ++c4) { const int c = 4 * hh + c4; const u32x4 lo4 = *(const LAS u32x4*)(hs + hb_base + c * hb_step), hi4 = *(const LAS u32x4*)(hs + hb_base + c * hb_step + hb_hi);
                    hB[c4][0] = lo4.x; hB[c4][1] = lo4.y; hB[c4][2] = lo4.z; hB[c4][3] = lo4.w; hB[c4][4] = hi4.x; hB[c4][5] = hi4.y; hB[c4][6] = hi4.z; hB[c4][7] = hi4.w; }
#pragma unroll
                for (int c4 = 0; c4 < 4; ++c4) { const int c = 4 * hh + c4; i32x8 a8; a8[0] = (int)ub[c].x; a8[1] = (int)ub[c].y; a8[2] = (int)ub[c].z; a8[3] = (int)ub[c].w; a8[4] = 0; a8[5] = 0; a8[6] = 0; a8[7] = 0;
                    const int sa = (int)(hh == 0 ? usc.x : usc.y);
                    switch (c4) {
                        case 0: acc = __builtin_amdgcn_mfma_scale_f32_16x16x128_f8f6f4(a8, hB[c4], acc, 4, 0, 0, sa, 0, sbv); break;
                        case 1: acc = __builtin_amdgcn_mfma_scale_f32_16x16x128_f8f6f4(a8, hB[c4], acc, 4, 0, 1, sa, 0, sbv); break;
                        case 2: acc = __builtin_amdgcn_mfma_scale_f32_16x16x128_f8f6f4(a8, hB[c4], acc, 4, 0, 2, sa, 0, sbv); break;
                        default: acc = __builtin_amdgcn_mfma_scale_f32_16x16x128_f8f6f4(a8, hB[c4], acc, 4, 0, 3, sa, 0, sbv); break; } }
            }
            __builtin_amdgcn_sched_barrier(0);
            if (g < 7) PEER_ISSUE_U(((g + 1) & 4) ? eB : eA, g + 1); else PEER_ISSUE_U(eAn, 0);
            __builtin_amdgcn_sched_barrier(0);
            float act[4];
#pragma unroll
            for (int rr = 0; rr < 4; ++rr) { const float dsum = acc[rr] + SWZ(acc[rr], 0x041F);
                const float gq = __int_as_float(__builtin_amdgcn_ds_bpermute((((g & 3) << 4) + 4 * lg + rr) << 2, __float_as_int((g & 4) ? gB : gA)));
                act[rr] = gelu_fast(dsum) * gq; }
#pragma unroll
            for (int p = 0; p < 8; ++p) {
                h16x2 dv[16]; const unsigned* wp = (const unsigned*)&vb[bf][p].a;
#pragma unroll
                for (int d = 0; d < 4; ++d) { dv[4 * d + 0] = __builtin_amdgcn_cvt_scalef32_pk_f16_fp4(wp[d], 1.0f, 0); dv[4 * d + 1] = __builtin_amdgcn_cvt_scalef32_pk_f16_fp4(wp[d], 1.0f, 1);
                    dv[4 * d + 2] = __builtin_amdgcn_cvt_scalef32_pk_f16_fp4(wp[d], 1.0f, 2); dv[4 * d + 3] = __builtin_amdgcn_cvt_scalef32_pk_f16_fp4(wp[d], 1.0f, 3); }
                const float bs = __uint_as_float((unsigned)vb[bf][p].sc << 16);
                const float a0 = __int_as_float(__builtin_amdgcn_readlane(__float_as_int(act[(2 * p) & 3]), 16 * ((2 * p) >> 2))), a1 = __int_as_float(__builtin_amdgcn_readlane(__float_as_int(act[(2 * p + 1) & 3]), 16 * ((2 * p + 1) >> 2)));
                const _Float16 ah = (_Float16)((hf ? a1 : a0) * bs); const h16x2 aa = {ah, ah};
                __builtin_amdgcn_sched_barrier(0);
                if (g < 6) PEER_ISSUE_V1(bf, ((g + 2) & 4) ? eB : eA, g + 2, p); else PEER_ISSUE_V1(bf, eAn, g - 6, p);
                __builtin_amdgcn_sched_barrier(0);
#pragma unroll
                for (int m = 0; m < 16; ++m) o[m] = __builtin_elementwise_fma(dv[m], aa, o[m]); }
            __builtin_amdgcn_sched_barrier(0);
        }

        float sq = 0.f; float4 xr[8];
#pragma unroll
        for (int j = 0; j < 8; ++j) { const f32x4 xv_ = *(const LAS f32x4*)(hs + 2080 + 4 * (128 * j + 4 * l32)); xr[j].x = xv_[0]; xr[j].y = xv_[1]; xr[j].z = xv_[2]; xr[j].w = xv_[3]; }
        __builtin_amdgcn_sched_barrier(0);
#pragma unroll
        for (int j = 0; j < 8; ++j) { const float4 g4 = *(const float4*)(GT2 + b * 1024 + 128 * j + 4 * l32);
            float ov[4] = {(float)o[2 * j].x, (float)o[2 * j].y, (float)o[2 * j + 1].x, (float)o[2 * j + 1].y};
#pragma unroll
            for (int i = 0; i < 4; ++i) { auto rr = __builtin_amdgcn_permlane32_swap(__float_as_uint(ov[i]), __float_as_uint(ov[i]), false, false); ov[i] = __uint_as_float(rr[0]) + __uint_as_float(rr[1]); }
            xr[j].x += g4.x * ov[0]; xr[j].y += g4.y * ov[1]; xr[j].z += g4.z * ov[2]; xr[j].w += g4.w * ov[3];
            sq += (xr[j].x * xr[j].x + xr[j].y * xr[j].y) + (xr[j].z * xr[j].z + xr[j].w * xr[j].w); }
        sq += SWZ(sq, 0x401F); sq += SWZ(sq, 0x201F); sq += SWZ(sq, 0x101F); sq += SWZ(sq, 0x081F); sq += SWZ(sq, 0x041F);
        const float rr = rsqrtf(sq * (1.f / D) + EPS);
#pragma unroll
        for (int j = 0; j < 8; ++j) if ((j >> 2) == hf) { const float4 g4 = *(const float4*)(GF + 128 * j + 4 * l32);
            float4 ov; ov.x = xr[j].x * rr * g4.x; ov.y = xr[j].y * rr * g4.y; ov.z = xr[j].z * rr * g4.z; ov.w = xr[j].w * rr * g4.w;
            __builtin_nontemporal_store((f32x4){ov.x, ov.y, ov.z, ov.w}, (f32x4*)(xout + (size_t)t * D + 128 * j + 4 * l32)); }
        eA = eAn; eB = eBn; gA = gAn; gB = gBn;
    }
#undef PEER_ISSUE_U
#undef PEER_ISSUE_V1
}

__device__ __forceinline__ int inproj_row(int n) {
    const int sec = n >> 9, m = n & 511;
    return (sec >> 1) * 1024 + (m >> 7) * 256 + (sec & 1) * 128 + (m & 127);
}
template <int MODE> __device__ __forceinline__ void transpose_tile(const float* __restrict__ W, int K, int N, bf16_t* __restrict__ Bt, int k0, int n0, float* tile  ) {
    const int tid = threadIdx.x;
#pragma unroll
    for (int p = 0; p < 2; ++p) { const int kk = p * 32 + (tid >> 4), nn = (tid & 15) * 4;
        const float4 v = *(const float4*)(W + (size_t)(k0 + kk) * N + n0 + nn);
        tile[kk * 65 + nn] = v.x; tile[kk * 65 + nn + 1] = v.y; tile[kk * 65 + nn + 2] = v.z; tile[kk * 65 + nn + 3] = v.w; }
    __syncthreads();
    { const int n = tid >> 3, kc = (tid & 7) * 8; const float* s = tile + kc * 65 + n;
      u32x4 o; o.x = pk_bf16(s[0], s[65]); o.y = pk_bf16(s[2 * 65], s[3 * 65]); o.z = pk_bf16(s[4 * 65], s[5 * 65]); o.w = pk_bf16(s[6 * 65], s[7 * 65]);
      const int row = MODE == 1 ? inproj_row(n0 + n) : (n0 + n);
      *(u32x4*)(Bt + (size_t)row * K + k0 + kc) = o; }
    __syncthreads();
}
__device__ __forceinline__ void phase0(const Params& P, float* ldsf, int bid, int nblk) {
    const int tid = phase_tid(), lane = tid & 63, wave = tid >> 6;
    unsigned char* ws = P.ws;
    for (int citem = bid; citem < 192; citem += nblk) {
        float* sl = ldsf;
        float* red = ldsf + 2048;
        for (int i = tid; i < 2048; i += 512) { const float cv = P.in[I_C][i]; sl[i] = cv * __builtin_amdgcn_rcpf(1.f + __builtin_amdgcn_exp2f(-1.4426950408889634f * cv)); }
        __syncthreads();
        const int c = tid & 31, kp = tid >> 5, n = citem * 32 + c;
        float a0 = 0.f, a1 = 0.f;
        const float* wp = P.in[I_WADA] + (size_t)(kp * 64) * 6144 + n;
#pragma unroll 8
        for (int k = 0; k < 64; ++k) { const float w = wp[(size_t)k * 6144]; a0 += sl[kp * 64 + k] * w; a1 += sl[1024 + kp * 64 + k] * w; }
        red[kp * 32 + c] = a0; red[512 + kp * 32 + c] = a1;
        __syncthreads();
        if (tid < 64) { const int b = tid >> 5, cc = tid & 31; float s = 0.f;
#pragma unroll
            for (int j = 0; j < 16; ++j) s += red[b * 512 + j * 32 + cc];
            ((float*)(ws + WS_COND))[b * 6144 + citem * 32 + cc] = s + P.in[I_BADA][citem * 32 + cc]; }
        __syncthreads();
    }
    for (int it = bid; it < 1280; it += nblk) {
        if (it < 512) transpose_tile<1>(P.in[I_WIN], 1024, 2048, (bf16_t*)(ws + WS_BT1), (it >> 5) * 64, (it & 31) * 64, ldsf);
        else if (it < 768) { const int r = it - 512; transpose_tile<0>(P.in[I_WOUT], 1024, 1024, (bf16_t*)(ws + WS_BT2), (r >> 4) * 64, (r & 15) * 64, ldsf); }
        else { const int r = it - 768; transpose_tile<0>(P.in[I_WQ], 1024, 2048, (bf16_t*)(ws + WS_BT3), (r >> 5) * 64, (r & 31) * 64, ldsf); }
    }
    const int gt = bid * 512 + tid, ngt = nblk * 512;
    for (int i = gt; i < 2048; i += ngt) ((float*)(ws + WS_BIAS1))[inproj_row(i)] = P.in[I_BIN][i];
    for (int i = gt; i < 8 * 2 * 128 * 128 / 4; i += ngt) { const float4 v = *(const float4*)(P.in[I_KEYS] + (size_t)i * 4); u32x2 o; o.x = pk_bf16(v.x, v.y); o.y = pk_bf16(v.z, v.w); *(u32x2*)((bf16_t*)(ws + WS_KEYS) + (size_t)i * 4) = o; }
    for (int i = gt; i < 8 * 128 * 128 / 4; i += ngt) { const int e = i * 4, s = e & 127, t = (e >> 7) & 127; float4 v = *(const float4*)(P.in[I_WSP] + (size_t)e);
        v.x = (s + 0 <= t) ? v.x : 0.f; v.y = (s + 1 <= t) ? v.y : 0.f; v.z = (s + 2 <= t) ? v.z : 0.f; v.w = (s + 3 <= t) ? v.w : 0.f;
        u32x2 o; o.x = pk_bf16(v.x, v.y); o.y = pk_bf16(v.z, v.w); *(u32x2*)((bf16_t*)(ws + WS_WSB) + (size_t)e) = o; }
    if (nblk != 256) { const int l32 = lane & 31, hf = lane >> 5;
      for (int r2 = bid * 8 + wave; r2 < NEXP / 2; r2 += nblk * 8) { const int r = 2 * r2 + hf;
          convert_row_umx(P.in[I_EU] + (size_t)r * D, ws + WS_UFP8 + (size_t)r * 512, ws + WS_USC + (size_t)r * 32, l32);
          convert_row<FMT_V>(P.in[I_EV] + (size_t)r * D, ws + WS_VFP8 + (size_t)r * RowFmt<FMT_V>::RSB, (float*)(ws + WS_VSC + (size_t)r * 64), l32); } }
}
__device__ __forceinline__ void phase0b(const Params& P, float* ldsf, int bid, int nblk) {
    const int tid = phase_tid(), lane = tid & 63, wave = tid >> 6;
    unsigned char* ws = P.ws; const float* cond = (const float*)(ws + WS_COND);
    float* G1 = ldsf; float* SH1 = ldsf + 2048;
    for (int i = tid; i < 2048; i += 512) { const int b = i >> 10, d = i & 1023; G1[i] = P.in[I_G1][d] * (1.f + cond[b * 6144 + 1024 + d]); SH1[i] = cond[b * 6144 + d]; }
    __syncthreads();
    {
        for (int n = bid * 8 + wave; n < 2048; n += nblk * 8) {
            const bf16_t* brow = (const bf16_t*)(ws + WS_BT3) + (size_t)n * 1024;
            float a0 = 0.f, a1 = 0.f;
#pragma unroll
            for (int j = 0; j < 2; ++j) { const u32x4 w = *(const u32x4*)(brow + j * 512 + lane * 8); const int k = j * 512 + lane * 8;
                const float wv[8] = {bf_lo(w.x), bf_hi(w.x), bf_lo(w.y), bf_hi(w.y), bf_lo(w.z), bf_hi(w.z), bf_lo(w.w), bf_hi(w.w)};
#pragma unroll
                for (int e = 0; e < 8; ++e) { a0 += wv[e] * cond[3 * 1024 + k + e]; a1 += wv[e] * cond[6144 + 3 * 1024 + k + e]; } }
            a0 = wave_sum(a0); a1 = wave_sum(a1);
            if (lane == 0) { ((float*)(ws + WS_QB))[n] = a0; ((float*)(ws + WS_QB))[2048 + n] = a1; }
        }
    }
    const float* x = P.in[I_X]; bf16_t* hb = (bf16_t*)(ws + WS_HB);
    for (int t = bid * 8 + wave; t < T; t += nblk * 8) {
        const int b = t >> 13;
        float4 v[4]; float s = 0.f;
#pragma unroll
        for (int j = 0; j < 4; ++j) { v[j] = *(const float4*)(x + (size_t)t * D + 256 * j + 4 * lane); s += (v[j].x * v[j].x + v[j].y * v[j].y) + (v[j].z * v[j].z + v[j].w * v[j].w); }
        s = wave_sum(s);
        const float r = rsqrtf(s * (1.f / D) + EPS);
#pragma unroll
        for (int j = 0; j < 4; ++j) { const float4 g4 = *(const float4*)(G1 + b * 1024 + 256 * j + 4 * lane), s4 = *(const float4*)(SH1 + b * 1024 + 256 * j + 4 * lane);
            u32x2 o; o.x = pk_bf16(v[j].x * r * g4.x + s4.x, v[j].y * r * g4.y + s4.y); o.y = pk_bf16(v[j].z * r * g4.z + s4.z, v[j].w * r * g4.w + s4.w);
            *(u32x2*)(hb + (size_t)t * D + 256 * j + 4 * lane) = o; }
    }
}
__device__ __forceinline__ void conv_item(const Params& P, int item, int lane) {
    const int rb = item >> 3, g = item & 7, c = g * 64 + lane, t0 = rb * 32, s0 = t0 & (SEQ - 1);
    const bf16_t* aglu = (const bf16_t*)(P.ws + WS_AGLU); bf16_t* ycat = (bf16_t*)(P.ws + WS_YCAT);
    float a[62];
    unsigned short raw[62];
#pragma unroll
    for (int i = 0; i < 62; ++i) { const int tr = (s0 - 30 + i) >= 0 ? (t0 - 30 + i) : t0; raw[i] = aglu[(size_t)tr * 512 + c]; }
    __builtin_amdgcn_sched_barrier(0);
#pragma unroll
    for (int i = 0; i < 62; ++i) a[i] = (s0 - 30 + i) >= 0 ? __uint_as_float((unsigned)raw[i] << 16) : 0.f;
    float w[31];
#pragma unroll
    for (int k = 0; k < 31; ++k) w[k] = P.in[I_CONVW][k * 512 + c];
    const float cb = P.in[I_CONVB][c], gl = P.in[I_GCLN][c], bl = P.in[I_BCLN][c];
    float y[32];
#pragma unroll
    for (int i = 0; i < 32; ++i) { float acc = cb;
#pragma unroll
        for (int k = 0; k < 31; ++k) acc += w[k] * a[i + k];
        y[i] = acc; }
#pragma unroll
    for (int hh = 0; hh < 2; ++hh) {
        float s16[16];
#pragma unroll
        for (int i = 0; i < 16; ++i) s16[i] = y[16 * hh + i];
        const float sm = reduce16(s16, lane);
        float d[16];
#pragma unroll
        for (int i = 0; i < 16; ++i) { const float mean = __int_as_float(__builtin_amdgcn_readlane(__float_as_int(sm), 4 * i)) * (1.f / 64.f); d[i] = y[16 * hh + i] - mean; s16[i] = d[i] * d[i]; }
        const float sv = reduce16(s16, lane);
#pragma unroll
        for (int i = 0; i < 16; ++i) { const float var = __int_as_float(__builtin_amdgcn_readlane(__float_as_int(sv), 4 * i)) * (1.f / 64.f);
            const float z = d[i] * rsqrtf(var + EPS) * gl + bl;
            const float o = z * __builtin_amdgcn_rcpf(1.f + __builtin_amdgcn_exp2f(-1.4426950408889634f * z));
            ycat[(size_t)(t0 + 16 * hh + i) * 1024 + c] = (bf16_t)(pk_bf16(o, 0.f) & 0xffffu); }
    }
}
constexpr int MIX_RS = 136;
__device__ __forceinline__ void mix_item(const Params& P, int item, LAS bf16_t* vnT  , int lane) {
    const int chunk = item >> 3, h = item & 7, tb = chunk * 128, cb = h * 64;
    const bf16_t* ug = (const bf16_t*)(P.ws + WS_UG); const bf16_t* vg = (const bf16_t*)(P.ws + WS_VG); const bf16_t* wsb = (const bf16_t*)(P.ws + WS_WSB) + (size_t)h * 128 * 128;
    bf16_t* ycat = (bf16_t*)(P.ws + WS_YCAT);
    const int fr = lane & 15, fq = lane >> 4;
    bf16x8 wf[8][4]; float bsv[8];
#pragma unroll
    for (int mt = 0; mt < 8; ++mt) { bsv[mt] = P.in[I_BSP][h * 128 + 16 * mt + fr];
#pragma unroll
        for (int ks = 0; ks < 4; ++ks) if (ks <= (mt >> 1)) wf[mt][ks] = *(const bf16x8*)(wsb + (size_t)(16 * mt + fr) * 128 + 32 * ks + 8 * fq); }
    { const int rr = lane >> 3, pc = lane & 7;
      float gl[8], bl[8];
#pragma unroll
      for (int j = 0; j < 8; ++j) { gl[j] = P.in[I_GVLN][cb + pc * 8 + j]; bl[j] = P.in[I_BVLN][cb + pc * 8 + j]; }
      u32x4 wv[16];
#pragma unroll
      for (int it = 0; it < 16; ++it) wv[it] = *(const u32x4*)(vg + (size_t)(tb + it * 8 + rr) * 512 + cb + pc * 8);
      __builtin_amdgcn_sched_barrier(0);
#pragma unroll
      for (int it = 0; it < 16; ++it) { const int t = it * 8 + rr;
          const u32x4 w = wv[it];
          float v[8] = {bf_lo(w.x), bf_hi(w.x), bf_lo(w.y), bf_hi(w.y), bf_lo(w.z), bf_hi(w.z), bf_lo(w.w), bf_hi(w.w)};
          float s = 0.f, ss = 0.f;
#pragma unroll
          for (int j = 0; j < 8; ++j) { s += v[j]; ss += v[j] * v[j]; }
          s += __shfl_xor(s, 1); ss += __shfl_xor(ss, 1); s += __shfl_xor(s, 2); ss += __shfl_xor(ss, 2); s += __shfl_xor(s, 4); ss += __shfl_xor(ss, 4);
          const float mean = s * (1.f / 64.f), var = fmaxf(ss * (1.f / 64.f) - mean * mean, 0.f), rstd = rsqrtf(var + EPS);
#pragma unroll
          for (int j = 0; j < 8; ++j) { const float o = (v[j] - mean) * rstd * gl[j] + bl[j]; vnT[(pc * 8 + j) * MIX_RS + t] = (bf16_t)(pk_bf16(o, 0.f) & 0xffffu); } }
    }
    u32x2 uwa[8][4];
#pragma unroll
    for (int mt = 0; mt < 8; ++mt)
#pragma unroll
        for (int nf = 0; nf < 4; ++nf) uwa[mt][nf] = *(const u32x2*)(ug + (size_t)(tb + 16 * mt + fr) * 512 + cb + 16 * fq + 4 * nf);
    asm volatile("s_waitcnt lgkmcnt(0)" ::: "memory");
#pragma unroll
    for (int mt = 0; mt < 8; ++mt) {
        f32x4 acc[4];
#pragma unroll
        for (int nf = 0; nf < 4; ++nf) acc[nf] = (f32x4){0.f, 0.f, 0.f, 0.f};
        const int t = 16 * mt + fr; const size_t ro = (size_t)(tb + t);
        const u32x2 (&uw)[4] = uwa[mt];
#pragma unroll
        for (int ks = 0; ks < 4; ++ks) if (ks <= (mt >> 1)) {
#pragma unroll
            for (int nf = 0; nf < 4; ++nf) { const bf16x8 vf = *(const LAS bf16x8*)(vnT + (16 * (fr >> 2) + 4 * nf + (fr & 3)) * MIX_RS + 32 * ks + 8 * fq);
                acc[nf] = __builtin_amdgcn_mfma_f32_16x16x32_bf16(vf, wf[mt][ks], acc[nf], 0, 0, 0); }
        }
        const float bs = bsv[mt];
#pragma unroll
        for (int nf = 0; nf < 4; ++nf) {
            u32x2 o; o.x = pk_bf16(bf_lo(uw[nf].x) * (acc[nf][0] + bs), bf_hi(uw[nf].x) * (acc[nf][1] + bs)); o.y = pk_bf16(bf_lo(uw[nf].y) * (acc[nf][2] + bs), bf_hi(uw[nf].y) * (acc[nf][3] + bs));
            *(u32x2*)(ycat + ro * 1024 + 512 + cb + 16 * fq + 4 * nf) = o; }
    }
}
__device__ __forceinline__ void phase1b(const Params& P, LAS unsigned char* lds, int bid, int nblk) {
    const int tid = phase_tid(), lane = tid & 63, wave = tid >> 6;
    LAS bf16_t* vnT = (LAS bf16_t*)lds + wave * 64 * MIX_RS;
    const int gw = bid * 8 + wave, ngw = nblk * 8;
    if (ngw == 2048) {
        if (gw < 1024) { mix_item(P, gw, vnT, lane); conv_item(P, gw, lane); }
        else { conv_item(P, gw, lane); conv_item(P, gw + 1024, lane); conv_item(P, gw + 2048, lane); }
    } else {
        for (int it = gw; it < 1024; it += ngw) mix_item(P, it, vnT, lane);
        for (int it = gw; it < 4096; it += ngw) conv_item(P, it, lane);
    }
}
constexpr int LDS_DYN = 147456;
template <int WHICH> __device__ __forceinline__ void phase_gemm(const Params& P, LAS unsigned char* lds, int bid, int nblk) {
    unsigned char* ws = P.ws;
    if constexpr (WHICH == 1) {
        pg8::Gemm g{(const bf16_t*)(ws + WS_HB), (const bf16_t*)(ws + WS_BT1), T, 2048, 1024}; pg8::StaticOrder S; S.init(T, 2048, nblk, bid);
        pg8::EpiInProj E{(const float*)(ws + WS_BIAS1), (bf16_t*)(ws + WS_AGLU), (bf16_t*)(ws + WS_UG), (bf16_t*)(ws + WS_VG)};
        pg8::gemm_phase<pg8::EpiInProj, pg8::StaticOrder, true, true>(lds, g, S, E);
    } else if constexpr (WHICH == 2) {
        pg8::Gemm g{(const bf16_t*)(ws + WS_YCAT), (const bf16_t*)(ws + WS_BT2), T, 1024, 1024}; pg8::StaticOrder S; S.init(T, 1024, nblk, bid);
        pg8::EpiOutProj E{P.in[I_X], P.in[I_BOUT], (const float*)(ws + WS_COND), P.in[I_G2], (bf16_t*)(ws + WS_X1B), (bf16_t*)(ws + WS_HB), (float*)(ws + WS_PART)};
        pg8::gemm_phase<pg8::EpiOutProj, pg8::StaticOrder, true, true>(lds, g, S, E);
    } else {
        pg8::Gemm g{(const bf16_t*)(ws + WS_HB), (const bf16_t*)(ws + WS_BT3), T, 2048, 1024}; pg8::StaticOrder S; S.init(T, 2048, nblk, bid);
        pg8::EpiQuery E{(const float*)(ws + WS_PART), (const float*)(ws + WS_QB), (bf16_t*)(ws + WS_Q)};
        pg8::gemm_phase<pg8::EpiQuery, pg8::StaticOrder, true, true>(lds, g, S, E);
    }
}
__device__ __forceinline__ int mono(int u) { return u ^ ((u >> 31) & 0x7fffffff); }
template <int N> __device__ __forceinline__ void bitonic_sort_desc(int (&a)[N]) {
#pragma unroll
    for (int k = 2; k <= N; k <<= 1)
#pragma unroll
        for (int j = k >> 1; j > 0; j >>= 1)
#pragma unroll
            for (int i = 0; i < N; ++i) { const int l = i ^ j;
                if (l > i) { const int hi = max(a[i], a[l]), lo = min(a[i], a[l]); if ((i & k) == 0) { a[i] = hi; a[l] = lo; } else { a[i] = lo; a[l] = hi; } } }
}
__device__ __forceinline__ void sort16_desc(int (&a)[16]) {
#define CE(i, j) { const int hi_ = max(a[i], a[j]), lo_ = min(a[i], a[j]); a[i] = hi_; a[j] = lo_; }
    CE(0,13) CE(1,12) CE(2,15) CE(3,14) CE(4,8) CE(5,6) CE(7,11) CE(9,10)
    CE(0,5) CE(1,7) CE(2,9) CE(3,4) CE(6,13) CE(8,14) CE(10,15) CE(11,12)
    CE(0,1) CE(2,3) CE(4,5) CE(6,8) CE(7,9) CE(10,11) CE(12,13) CE(14,15)
    CE(0,2) CE(1,3) CE(4,10) CE(5,11) CE(6,7) CE(8,9) CE(12,14) CE(13,15)
    CE(1,2) CE(3,12) CE(4,6) CE(5,7) CE(8,10) CE(9,11) CE(13,14)
    CE(1,4) CE(2,6) CE(5,8) CE(7,10) CE(9,13) CE(11,14)
    CE(2,4) CE(3,6) CE(9,12) CE(11,13)
    CE(3,5) CE(6,8) CE(7,9) CE(10,12)
    CE(3,4) CE(5,6) CE(7,8) CE(9,10) CE(11,12)
    CE(6,7) CE(8,9)
#undef CE
}
__device__ __forceinline__ void merge_top16(int (&a)[16], const int (&b)[16]) {
#pragma unroll
    for (int j = 0; j < 16; ++j) a[j] = max(a[j], b[15 - j]);
#pragma unroll
    for (int j = 8; j > 0; j >>= 1)
#pragma unroll
        for (int i = 0; i < 16; ++i) { const int l = i ^ j; if (l > i) { const int hi = max(a[i], a[l]), lo = min(a[i], a[l]); a[i] = hi; a[l] = lo; } }
}
__device__ __forceinline__ void merge_quad(int (&a)[16]) {
    int b[16];
#pragma unroll
    for (int j = 0; j < 16; ++j) b[j] = __builtin_amdgcn_ds_swizzle(a[j], 0x401F);
    merge_top16(a, b);
#pragma unroll
    for (int j = 0; j < 16; ++j) b[j] = __shfl_xor(a[j], 32);
    merge_top16(a, b);
}
__device__ __forceinline__ int sel4(int fq, int x0, int x1, int x2, int x3) { const int lo = (fq & 1) ? x1 : x0, hi = (fq & 1) ? x3 : x2; return (fq & 2) ? hi : lo; }
__device__ constexpr int cand_ab(int fq, int s) {
    if (fq == 0) return (0 << 4) | s;
    if (fq == 1) return s < 8 ? ((1 << 4) | s) : (s < 13 ? ((2 << 4) | (s - 8)) : -1);
    if (fq == 2) return s < 4 ? ((3 << 4) | s) : (s < 7 ? ((4 << 4) | (s - 4)) : (s < 9 ? ((5 << 4) | (s - 7)) : (s < 11 ? ((6 << 4) | (s - 9)) : (s < 13 ? ((7 << 4) | (s - 11)) : -1))));
    return s < 8 ? (((8 + s) << 4) | 0) : -1;
}
constexpr int TK_RS = 136;
__device__ __forceinline__ void phase3c(const Params& P, LAS unsigned char* lds, int bid, int nblk) {
    const int tid = phase_tid(), lane = tid & 63, wave = tid >> 6, fr = lane & 15, fq = lane >> 4;
    LAS bf16_t* kl = (LAS bf16_t*)lds;
    LAS unsigned char* isc = lds + 2 * 128 * TK_RS * 2 + wave * 512;
    const bf16_t* q = (const bf16_t*)(P.ws + WS_Q); const bf16_t* keysb = (const bf16_t*)(P.ws + WS_KEYS);
    int* eidx = (int*)(P.ws + WS_EIDX); float* gate = (float*)(P.ws + WS_GATE);
    int cur_h = -1;
    bf16x8 qf[2][4];
#define TK_LOADQ(dst, it_) do { const int h_ = (it_) & 7, t0_ = ((it_) >> 3) * 128 + wave * 16; \
        _Pragma("unroll") for (int i_ = 0; i_ < 2; ++i_) _Pragma("unroll") for (int ks_ = 0; ks_ < 4; ++ks_) dst[i_][ks_] = *(const bf16x8*)(q + (size_t)(t0_ + fr) * 2048 + h_ * 256 + i_ * 128 + 32 * ks_ + 8 * fq); } while (0)
    if (bid < 1024) TK_LOADQ(qf, bid);
    for (int item = bid; item < 1024; item += nblk) {
        const int h = item & 7, tile = item >> 3;
        bf16x8 qn[2][4]; const int nitem = item + nblk < 1024 ? item + nblk : item;
        TK_LOADQ(qn, nitem);
        const bool cv = (nblk == 256); const int cv_r = 2 * ((bid * 8 + wave) * 4 + (item >> 8)) + (lane >> 5), cv_l = lane & 31;
        float4 cu[8], cw[8];
        if (cv) {
#pragma unroll
            for (int j = 0; j < 8; ++j) cu[j] = *(const float4*)(P.in[I_EU] + (size_t)cv_r * D + 32 * cv_l + 4 * j);
#pragma unroll
            for (int j = 0; j < 8; ++j) cw[j] = *(const float4*)(P.in[I_EV] + (size_t)cv_r * D + 128 * j + 4 * cv_l);
        }
        __builtin_amdgcn_sched_barrier(0);
        if (h != cur_h) {
            __syncthreads();
            for (int c = tid; c < 4096; c += 512) { const int row = c >> 4, pc = c & 15;
                const u32x4 v = *(const u32x4*)(keysb + ((size_t)h * 256 + row) * 128 + pc * 8);
                *(LAS u32x4*)(kl + row * TK_RS + pc * 8) = v; }
            __syncthreads();
            cur_h = h;
        }
        const int t0 = tile * 128 + wave * 16;
        int L[2][16];
#pragma unroll
        for (int i = 0; i < 2; ++i) {
            f32x4 S[8];
#pragma unroll
            for (int nf = 0; nf < 8; ++nf) { S[nf] = (f32x4){0.f, 0.f, 0.f, 0.f};
#pragma unroll
                for (int ks = 0; ks < 4; ++ks) { const bf16x8 kf = *(const LAS bf16x8*)(kl + (i * 128 + 16 * nf + fr) * TK_RS + 32 * ks + 8 * fq);
                    S[nf] = __builtin_amdgcn_mfma_f32_16x16x32_bf16(kf, qf[i][ks], S[nf], 0, 0, 0); } }
            int a0[16], a1[16];
#pragma unroll
            for (int nf = 0; nf < 4; ++nf)
#pragma unroll
                for (int r = 0; r < 4; ++r) { a0[4 * nf + r] = (mono(__float_as_int(S[nf][r])) & ~127) | (16 * nf + 4 * fq + r);
                                              a1[4 * nf + r] = (mono(__float_as_int(S[nf + 4][r])) & ~127) | (16 * (nf + 4) + 4 * fq + r); }
            sort16_desc(a0); sort16_desc(a1);
            merge_top16(a0, a1);
            merge_quad(a0);
#pragma unroll
            for (int j = 0; j < 16; ++j) L[i][j] = a0[j];
        }
        if (fq < 2) {
            u32x4 w; unsigned* wp = (unsigned*)&w;
#pragma unroll
            for (int d = 0; d < 4; ++d) { const int x0 = fq ? L[1][4 * d] : L[0][4 * d], x1 = fq ? L[1][4 * d + 1] : L[0][4 * d + 1], x2 = fq ? L[1][4 * d + 2] : L[0][4 * d + 2], x3 = fq ? L[1][4 * d + 3] : L[0][4 * d + 3];
                wp[d] = (unsigned)(x0 & 127) | ((unsigned)(x1 & 127) << 8) | ((unsigned)(x2 & 127) << 16) | ((unsigned)(x3 & 127) << 24); }
            *(LAS u32x4*)(isc + fr * 32 + fq * 16) = w;
        }
        int cnd[16];
#pragma unroll
        for (int s = 0; s < 16; ++s) {
            constexpr int NEG = (int)0x80000000;
            const int c0 = cand_ab(0, s), c1 = cand_ab(1, s), c2 = cand_ab(2, s), c3 = cand_ab(3, s);
            const int ka = sel4(fq, L[0][c0 >> 4], c1 >= 0 ? L[0][(c1 >> 4) & 15] : 0, c2 >= 0 ? L[0][(c2 >> 4) & 15] : 0, c3 >= 0 ? L[0][(c3 >> 4) & 15] : 0);
            const int kb = sel4(fq, L[1][c0 & 15], c1 >= 0 ? L[1][c1 & 15] : 0, c2 >= 0 ? L[1][c2 & 15] : 0, c3 >= 0 ? L[1][c3 & 15] : 0);
            const int code = sel4(fq, c0, c1, c2, c3);
            const float sum = __int_as_float(mono(ka & ~127)) + __int_as_float(mono(kb & ~127));
            const int key = (mono(__float_as_int(sum)) & ~255) | (code & 255);
            cnd[s] = code < 0 ? NEG : key;
        }
        sort16_desc(cnd);
        merge_quad(cnd);
        const float vmax = __int_as_float(mono(cnd[0] & ~255));
        int kk[4]; float ee[4]; float esum = 0.f;
#pragma unroll
        for (int j = 0; j < 4; ++j) { kk[j] = sel4(fq, cnd[j], cnd[4 + j], cnd[8 + j], cnd[12 + j]);
            ee[j] = __builtin_amdgcn_exp2f((__int_as_float(mono(kk[j] & ~255)) - vmax) * 1.4426950408889634f); esum += ee[j]; }
        esum += __int_as_float(__builtin_amdgcn_ds_swizzle(__float_as_int(esum), 0x401F)); esum += __shfl_xor(esum, 32);
        const float rs = __builtin_amdgcn_rcpf(esum);
        asm volatile("s_waitcnt lgkmcnt(0)" ::: "memory");
        int4 eo; float4 go; int* ep = (int*)&eo; float* gp = (float*)&go;
#pragma unroll
        for (int j = 0; j < 4; ++j) { const int code = kk[j] & 255; const int ia = isc[fr * 32 + (code >> 4)], ib = isc[fr * 32 + 16 + (code & 15)]; ep[j] = ia * 128 + ib; gp[j] = ee[j] * rs; }
        *(int4*)(eidx + (size_t)(t0 + fr) * 128 + h * 16 + 4 * fq) = eo;
        *(float4*)(gate + (size_t)(t0 + fr) * 128 + h * 16 + 4 * fq) = go;
        if (cv) { convert_row_umx_from(cu, P.ws + WS_UFP8 + (size_t)cv_r * 512, P.ws + WS_USC + (size_t)cv_r * 32, cv_l);
                  convert_row_from<FMT_V>(cw, P.ws + WS_VFP8 + (size_t)cv_r * RowFmt<FMT_V>::RSB, (float*)(P.ws + WS_VSC + (size_t)cv_r * 64), cv_l); }
#pragma unroll
        for (int i_ = 0; i_ < 2; ++i_)
#pragma unroll
            for (int ks_ = 0; ks_ < 4; ++ks_) qf[i_][ks_] = qn[i_][ks_];
    }
#undef TK_LOADQ
    __syncthreads();
}
#define XB_TMO      128
#define XB_XCNT(j)  (256  + 64 * (j))
#define XB_XSUB(j)  (1280 + 64 * (j))
#define XB_XGEN(j)  (2304 + 64 * (j))
#define XB_TOP      3328
#define XB_TOPGEN   3392
#define XCD_BAR_WORDS 3456
#define XB_SPIN_CAP (1u << 18)

__device__ __forceinline__ unsigned xb_ld(unsigned* p)              { return __hip_atomic_load(p, __ATOMIC_RELAXED, __HIP_MEMORY_SCOPE_AGENT); }
__device__ __forceinline__ unsigned xb_add(unsigned* p, unsigned v) { return __hip_atomic_fetch_add(p, v, __ATOMIC_RELAXED, __HIP_MEMORY_SCOPE_AGENT); }
__device__ __forceinline__ unsigned xb_xcc_id() { return (unsigned)__builtin_amdgcn_s_getreg((3 << 11) | 20) & 0xFu; }
#define XB_SPIN(cond, bar) do { unsigned _sp = 0; while (cond) { __builtin_amdgcn_s_sleep(1); \
    if ((++_sp & 255u) == 0u) { if (xb_ld(&(bar)[XB_TMO])) break; if (_sp > XB_SPIN_CAP) { atomicAdd(&(bar)[XB_TMO], 1u); break; } } } } while (0)

struct XcdBarrier {
    unsigned* bar; unsigned x;
    volatile LAS unsigned* st;
};

__device__ __forceinline__ XcdBarrier xcd_barrier_post(unsigned* bar, volatile LAS unsigned* st) {
    XcdBarrier b; b.bar = bar; b.x = xb_xcc_id(); b.st = st;
    if (threadIdx.x == 0) (void)xb_add(&bar[XB_XCNT(b.x)], 1u);
    return b;
}
__device__ __forceinline__ void xcd_barrier_complete(unsigned* bar, unsigned x, unsigned& nloc, unsigned& nx) {
    const unsigned G = gridDim.x * gridDim.y * gridDim.z;
    unsigned sum, cnt, mine, sp = 0u;
    for (;;) {
        sum = 0u; cnt = 0u; mine = 0u;
#pragma unroll
        for (unsigned j = 0; j < 16; ++j) { const unsigned c = xb_ld(&bar[XB_XCNT(j)]); sum += c; cnt += (c > 0u) ? 1u : 0u; mine = (j == x) ? c : mine; }
        if (sum == G) break;
        __builtin_amdgcn_s_sleep(1);
        if ((++sp & 255u) == 0u) { if (xb_ld(&bar[XB_TMO])) break; if (sp > XB_SPIN_CAP) { atomicAdd(&bar[XB_TMO], 1u); break; } }
    }
    nloc = mine > 0u ? mine : 1u; nx = cnt > 0u ? cnt : 1u;
}

__device__ __forceinline__ void xcd_barrier(const XcdBarrier& b) {
    asm volatile("s_waitcnt vmcnt(0)" ::: "memory");
    __syncthreads();
    if (threadIdx.x == 0) {
        unsigned* bar = b.bar;
        __builtin_amdgcn_s_waitcnt(0);
        unsigned nloc = b.st[0], nx = b.st[1];
        if (nloc == 0u) { xcd_barrier_complete(bar, b.x, nloc, nx); b.st[0] = nloc; b.st[1] = nx; }
        const unsigned old = xb_add(&bar[XB_XSUB(b.x)], 1u);
        const unsigned gen = old / nloc;
        if (old + 1u == (gen + 1u) * nloc) {
            __builtin_amdgcn_fence(__ATOMIC_RELEASE, "agent");
            asm volatile("s_waitcnt vmcnt(0)" ::: "memory");
            const unsigned og = xb_add(&bar[XB_TOP], 1u);
            const unsigned tg = og / nx;
            if (og + 1u == (tg + 1u) * nx) xb_add(&bar[XB_TOPGEN], 1u);
            else XB_SPIN(xb_ld(&bar[XB_TOPGEN]) == tg, bar);
            __builtin_amdgcn_fence(__ATOMIC_ACQUIRE, "agent");
            xb_add(&bar[XB_XGEN(b.x)], 1u);
            asm volatile("s_waitcnt vmcnt(0)" ::: "memory");
        } else {
            XB_SPIN(xb_ld(&bar[XB_XGEN(b.x)]) == gen, bar);
            __builtin_amdgcn_fence(__ATOMIC_ACQUIRE, "agent");
            asm volatile("s_waitcnt vmcnt(0)" ::: "memory");
        }
    }
    __syncthreads();
}

constexpr int LDS_BARST = LDS_DYN - 64;
constexpr int CW_BAR = 1024;
constexpr size_t CTL_ZERO_BYTES = 32768;
__global__ void __launch_bounds__(512, 2) k_mega(Params P) {
    extern __shared__ __attribute__((aligned(16))) unsigned char lds[];
    LAS unsigned char* l3 = (LAS unsigned char*)lds;
    const int bid = blockIdx.x, nblk = gridDim.x;
    volatile LAS unsigned* st = (volatile LAS unsigned*)(l3 + LDS_BARST);
    if (threadIdx.x < 2) st[threadIdx.x] = 0u;
    __syncthreads();
    XcdBarrier bar = xcd_barrier_post((unsigned*)(P.ws + WS_CTL) + CW_BAR, st);
#define GRID_BAR() do { xcd_barrier(bar); } while (0)
#ifndef REP_MASK
#define REP_MASK 0
#endif
#define RUN(k, call) do { call; GRID_BAR(); if (REP_MASK & (1 << (k))) { call; GRID_BAR(); } } while (0)
    RUN(0, phase0(P, (float*)lds, bid, nblk));
    RUN(1, phase0b(P, (float*)lds, bid, nblk));
    RUN(2, phase_gemm<1>(P, l3, bid, nblk));
    RUN(3, phase1b(P, l3, bid, nblk));
    RUN(4, phase_gemm<2>(P, l3, bid, nblk));
    RUN(5, phase_gemm<3>(P, l3, bid, nblk));
    RUN(6, phase3c(P, l3, bid, nblk));
#undef RUN
#ifdef PEER_PROBE
    phase_peer<PEER_PROBE>(P, (float*)lds, bid, nblk, (float*)(P.ws + WS_Q));
    GRID_BAR();
#endif
    phase_peer<0>(P, (float*)lds, bid, nblk, P.out);
#undef GRID_BAR
}

extern "C" void kernel_launch(void* const* d_in, const int* in_sizes, int n_in, void* d_out, int out_size, void* d_ws, size_t ws_size, hipStream_t stream) {
    if (n_in != 23 || ws_size < 256 * MiB) { fprintf(stderr, "kernel_launch: unexpected n_in %d or ws_size %zu\n", n_in, ws_size); return; }
    static int grid = 0;
    if (grid == 0) {
        int dev = 0, cus = 0;
        if (hipGetDevice(&dev) != hipSuccess || hipDeviceGetAttribute(&cus, hipDeviceAttributeMultiprocessorCount, dev) != hipSuccess || cus <= 0) { fprintf(stderr, "kernel_launch: device query failed\n"); grid = -1; return; }
        if (hipFuncSetAttribute((const void*)k_mega, hipFuncAttributeMaxDynamicSharedMemorySize, LDS_DYN) != hipSuccess) { fprintf(stderr, "kernel_launch: hipFuncSetAttribute failed\n"); grid = -1; return; }
        int per_cu = 0;
        if (hipOccupancyMaxActiveBlocksPerMultiprocessor(&per_cu, (const void*)k_mega, 512, LDS_DYN) != hipSuccess || per_cu < 1) { fprintf(stderr, "kernel_launch: occupancy query says %d blocks/CU\n", per_cu); }
        (void)hipGetLastError();
        grid = cus;
    }
    if (grid < 0) return;
    Params P{};
    for (int i = 0; i < 23; ++i) P.in[i] = (const float*)d_in[i];
    P.out = (float*)d_out; P.ws = (unsigned char*)d_ws;
    hipMemsetAsync((char*)d_ws + WS_CTL, 0, CTL_ZERO_BYTES, stream);
    hipLaunchKernelGGL(k_mega, dim3(grid), dim3(512), LDS_DYN, stream, P);
}
```

```cpp
#include <hip/hip_runtime.h>
#include <cstdio>
#include <cstdint>

constexpr int D = 1024, BATCH = 2, SEQ = 8192, T = BATCH * SEQ;
constexpr int DCONV = 512, DG = 512, NPROJ = 2048, CW = 31, CHUNK = 128;
constexpr int NKEYS = 128, NEXP = 16384, PH = 8, DKEY = 256, DHALF = 128, TOPK = 16;
constexpr float EPS = 1e-6f;

__device__ __forceinline__ float gelu_tanh(float x) { return 0.5f * x * (1.f + tanhf(0.7978845608028654f * (x + 0.044715f * x * x * x))); }
__device__ __forceinline__ float sigmoidf_(float x) { return 1.f / (1.f + expf(-x)); }
__device__ __forceinline__ int phase_tid() { int t = threadIdx.x; asm volatile("" : "+v"(t)); return t; }
__device__ __forceinline__ float wave_sum(float v) {
#pragma unroll
    for (int o = 1; o < 64; o <<= 1) v += __shfl_xor(v, o);
    return v;
}

typedef float f32x2 __attribute__((ext_vector_type(2)));
__device__ __forceinline__ float gelu_fast(float x) {
    const float z = x * (0.7978845608028654f + 0.035677408136300125f * x * x);
    return x * __builtin_amdgcn_rcpf(1.f + __builtin_amdgcn_exp2f(-2.885390081777927f * z));
}
#define SWZ(v, pat) __int_as_float(__builtin_amdgcn_ds_swizzle(__float_as_int(v), pat))
__device__ __forceinline__ float reduce16(const float (&s)[16], int lane) {
    float t[8];
#pragma unroll
    for (int k = 0; k < 8; ++k) { auto r = __builtin_amdgcn_permlane32_swap(__float_as_uint(s[k]), __float_as_uint(s[k + 8]), false, false); t[k] = __uint_as_float(r[0]) + __uint_as_float(r[1]); }
    const bool b4 = lane & 16, b3 = lane & 8, b2 = lane & 4;
    float u[4];
#pragma unroll
    for (int k = 0; k < 4; ++k) { const float keep = b4 ? t[k + 4] : t[k], send = b4 ? t[k] : t[k + 4]; u[k] = keep + SWZ(send, 0x401F); }
    float v[2];
#pragma unroll
    for (int k = 0; k < 2; ++k) { const float keep = b3 ? u[k + 2] : u[k], send = b3 ? u[k] : u[k + 2]; v[k] = keep + SWZ(send, 0x201F); }
    const float keep = b2 ? v[1] : v[0], send = b2 ? v[0] : v[1];
    float w = keep + SWZ(send, 0x101F);
    w += SWZ(w, 0x081F); w += SWZ(w, 0x041F);
    return w;
}
namespace pg8 {
#define PG8_LAS __attribute__((address_space(3)))
typedef unsigned short bf16_t;
typedef short bf16x8 __attribute__((ext_vector_type(8)));
typedef float f32x4 __attribute__((ext_vector_type(4)));
typedef unsigned u32x4 __attribute__((ext_vector_type(4)));
constexpr int BM = 256, BK = 64, HALF = 128, HTB = HALF * BK * 2  , STAGE_BYTES = 8 * HTB, NXCD = 8, WGM = 8;

__host__ __device__ __forceinline__ int lds_byte(int r, int c) { const int st = (r >> 4) * 2 + (c >> 5), rr = r & 15, cc = c & 31, ob = rr * 64 + cc * 2; return st * 1024 + (ob ^ (((ob >> 9) & 1) << 5)); }
__host__ __device__ __forceinline__ void stage_rc(int b, int& R, int& C) { const int st = b / 1024, sb = b % 1024, swz = sb ^ (((sb >> 9) & 1) << 5); R = (st >> 1) * 16 + swz / 64; C = (st & 1) * 32 + (swz % 64) / 2; }
__host__ __device__ __forceinline__ int perm32(int rho) { const int n = rho >> 4, i = rho & 15; return 8 * (i >> 2) + 4 * n + (i & 3); }

struct Unit { int pm, pn; };
struct Gemm { const bf16_t* A; const bf16_t* Bt; int M, N, K; };

struct StaticOrder {
    int nM, nN, nwg, G, c;
    __host__ __device__ void init(int M, int N, int G_, int c_) { nM = M / BM; nN = N / BM; nwg = nM * nN; G = G_; c = c_; }
    __host__ __device__ bool next(int i, Unit& u) const {
        const long L = (long)i * G + c; if (L >= nwg) return false;
        int wgid = (int)L; { const int q = nwg / NXCD, r = nwg % NXCD, xcd = wgid % NXCD, off = wgid / NXCD; wgid = (xcd < r ? xcd * (q + 1) : r * (q + 1) + (xcd - r) * q) + off; }
        const int nig = WGM * nN, gid = wgid / nig, fm = gid * WGM, gsz = (nM - fm) < WGM ? (nM - fm) : WGM;
        u.pm = fm + ((wgid % nig) % gsz); u.pn = (wgid % nig) / gsz; return true;
    }
    __device__ __forceinline__ void a_ready(const Unit&) const {}
    __device__ __forceinline__ void done(const Unit&) const {}
};


__device__ __forceinline__ unsigned cvt_pk_bf16(float lo, float hi) { unsigned r; asm volatile("v_cvt_pk_bf16_f32 %0, %1, %2" : "=v"(r) : "v"(lo), "v"(hi)); return r; }
__device__ __forceinline__ float sigm_fast(float x) { return __builtin_amdgcn_rcpf(1.f + __builtin_amdgcn_exp2f(-1.4426950408889634f * x)); }
__device__ __forceinline__ float gelu_f(float x) { const float z = x * (0.7978845608028654f + 0.035677408136300125f * x * x); return x * __builtin_amdgcn_rcpf(1.f + __builtin_amdgcn_exp2f(-2.885390081777927f * z)); }
typedef unsigned u32x2 __attribute__((ext_vector_type(2)));

struct EpiInProj {
    static constexpr bool PERM = true, AFTER_DRAIN = false;
    const float* bias; bf16_t* aglu; bf16_t* ug; bf16_t* vg;
    __device__ __forceinline__ void operator()(const f32x4 (&acc)[2][2][4][2], const Unit& u, int wr, int wc, int fr, int fq) const {
        const int row0 = u.pm * BM + wr * 64 + fr, cc = wc * 32 + 8 * fq;
        f32x4 bv[2][2];
#pragma unroll
        for (int bj = 0; bj < 2; ++bj)
#pragma unroll
            for (int n = 0; n < 2; ++n) bv[bj][n] = *(const f32x4*)(bias + u.pn * BM + bj * HALF + cc + 4 * n);
        if (u.pn < 4) {
            bf16_t* base = aglu + u.pn * HALF + cc;
#pragma unroll
            for (int ai = 0; ai < 2; ++ai)
#pragma unroll
                for (int m = 0; m < 4; ++m) { const size_t row = (size_t)(row0 + ai * HALF + m * 16);
                    float a[8];
#pragma unroll
                    for (int n = 0; n < 2; ++n) { const f32x4 v = acc[ai][0][m][n] + bv[0][n], g = acc[ai][1][m][n] + bv[1][n];
#pragma unroll
                        for (int j = 0; j < 4; ++j) a[4 * n + j] = v[j] * sigm_fast(g[j]); }
                    u32x4 w; w.x = cvt_pk_bf16(a[0], a[1]); w.y = cvt_pk_bf16(a[2], a[3]); w.z = cvt_pk_bf16(a[4], a[5]); w.w = cvt_pk_bf16(a[6], a[7]);
                    *(u32x4*)(base + row * 512) = w; }
        } else {
            const int off = (u.pn - 4) * HALF + cc;
#pragma unroll
            for (int ai = 0; ai < 2; ++ai)
#pragma unroll
                for (int m = 0; m < 4; ++m) { const size_t row = (size_t)(row0 + ai * HALF + m * 16);
#pragma unroll
                    for (int bj = 0; bj < 2; ++bj) { float a[8];
#pragma unroll
                        for (int n = 0; n < 2; ++n) { const f32x4 v = acc[ai][bj][m][n] + bv[bj][n];
#pragma unroll
                            for (int j = 0; j < 4; ++j) a[4 * n + j] = gelu_f(v[j]); }
                        u32x4 w; w.x = cvt_pk_bf16(a[0], a[1]); w.y = cvt_pk_bf16(a[2], a[3]); w.z = cvt_pk_bf16(a[4], a[5]); w.w = cvt_pk_bf16(a[6], a[7]);
                        *(u32x4*)((bj == 0 ? ug : vg) + row * 512 + off) = w; } }
        }
    }
};

struct EpiOutProj {
    static constexpr bool PERM = true, AFTER_DRAIN = false;
    const float* x; const float* b_out; const float* cond; const float* g2; bf16_t* x1; bf16_t* xg; float* part;
    __device__ __forceinline__ void operator()(const f32x4 (&acc)[2][2][4][2], const Unit& u, int wr, int wc, int fr, int fq) const {
        const int row0 = u.pm * BM + wr * 64 + fr, col0 = u.pn * BM + wc * 32 + 8 * fq, b = (u.pm * BM) >> 13;
        const float* cb = cond + b * 6144;
        float ssq[2][4];
#pragma unroll
        for (int ai = 0; ai < 2; ++ai)
#pragma unroll
            for (int m = 0; m < 4; ++m) ssq[ai][m] = 0.f;
#pragma unroll
        for (int bj = 0; bj < 2; ++bj) { const int col = col0 + bj * HALF;
            f32x4 bo[2], gt[2], gg[2];
#pragma unroll
            for (int n = 0; n < 2; ++n) { bo[n] = *(const f32x4*)(b_out + col + 4 * n); gt[n] = *(const f32x4*)(cb + 2048 + col + 4 * n); gg[n] = *(const f32x4*)(g2 + col + 4 * n) * (*(const f32x4*)(cb + 4096 + col + 4 * n) + 1.0f); }
#pragma unroll
            for (int am = 0; am < 4; ++am) { const int ai = am >> 1;
                f32x4 xl[4][2];
#pragma unroll
                for (int m = 2 * (am & 1); m < 2 * (am & 1) + 2; ++m)
#pragma unroll
                    for (int n = 0; n < 2; ++n) xl[m][n] = *(const f32x4*)(x + (size_t)(row0 + ai * HALF + m * 16) * 1024 + col + 4 * n);
                __builtin_amdgcn_sched_barrier(0);
#pragma unroll
                for (int m = 2 * (am & 1); m < 2 * (am & 1) + 2; ++m) { const size_t off = (size_t)(row0 + ai * HALF + m * 16) * 1024 + col;
                    const f32x4 r0 = xl[m][0] + gt[0] * (acc[ai][bj][m][0] + bo[0]), r1 = xl[m][1] + gt[1] * (acc[ai][bj][m][1] + bo[1]);
                    { u32x4 wx; wx.x = cvt_pk_bf16(r0[0], r0[1]); wx.y = cvt_pk_bf16(r0[2], r0[3]); wx.z = cvt_pk_bf16(r1[0], r1[1]); wx.w = cvt_pk_bf16(r1[2], r1[3]); *(u32x4*)(x1 + off) = wx; }
                    ssq[ai][m] += ((r0[0] * r0[0] + r0[1] * r0[1]) + (r0[2] * r0[2] + r0[3] * r0[3])) + ((r1[0] * r1[0] + r1[1] * r1[1]) + (r1[2] * r1[2] + r1[3] * r1[3]));
                    const f32x4 h0 = r0 * gg[0], h1 = r1 * gg[1]; u32x4 w; w.x = cvt_pk_bf16(h0[0], h0[1]); w.y = cvt_pk_bf16(h0[2], h0[3]); w.z = cvt_pk_bf16(h1[0], h1[1]); w.w = cvt_pk_bf16(h1[2], h1[3]);
                    *(u32x4*)(xg + off) = w; } } }
#pragma unroll
        for (int ai = 0; ai < 2; ++ai)
#pragma unroll
            for (int m = 0; m < 4; ++m) { float s = ssq[ai][m]; s += __shfl_xor(s, 16); s += __shfl_xor(s, 32);
                if (fq == 0) part[(size_t)(row0 + ai * HALF + m * 16) * 16 + u.pn * 4 + wc] = s; }
    }
};

struct EpiQuery {
    static constexpr bool PERM = true, AFTER_DRAIN = false;
    const float* part; const float* qb; bf16_t* q;
    __device__ __forceinline__ void operator()(const f32x4 (&acc)[2][2][4][2], const Unit& u, int wr, int wc, int fr, int fq) const {
        const int row0 = u.pm * BM + wr * 64 + fr, col0 = u.pn * BM + wc * 32 + 8 * fq, b = (u.pm * BM) >> 13;
        f32x4 qv[2][2];
#pragma unroll
        for (int bj = 0; bj < 2; ++bj)
#pragma unroll
            for (int n = 0; n < 2; ++n) qv[bj][n] = *(const f32x4*)(qb + b * 2048 + col0 + bj * HALF + 4 * n);
#pragma unroll
        for (int ai = 0; ai < 2; ++ai) {
            f32x4 pl[4];
#pragma unroll
            for (int m = 0; m < 4; ++m) pl[m] = *(const f32x4*)(part + (size_t)(row0 + ai * HALF + m * 16) * 16 + 4 * fq);
            __builtin_amdgcn_sched_barrier(0);
#pragma unroll
            for (int m = 0; m < 4; ++m) { const size_t row = (size_t)(row0 + ai * HALF + m * 16);
                const f32x4 p4 = pl[m];
                float s = (p4[0] + p4[1]) + (p4[2] + p4[3]); s += __shfl_xor(s, 16); s += __shfl_xor(s, 32);
                const float r = rsqrtf(s * (1.f / 1024.f) + 1e-6f);
#pragma unroll
                for (int bj = 0; bj < 2; ++bj) { const f32x4 v0 = acc[ai][bj][m][0] * r + qv[bj][0], v1 = acc[ai][bj][m][1] * r + qv[bj][1];
                    u32x4 w; w.x = cvt_pk_bf16(v0[0], v0[1]); w.y = cvt_pk_bf16(v0[2], v0[3]); w.z = cvt_pk_bf16(v1[0], v1[1]); w.w = cvt_pk_bf16(v1[2], v1[3]);
                    *(u32x4*)(q + row * 2048 + col0 + bj * HALF) = w; } } }
    }
};
template <class Epi, class Sched, bool ALIGN_EPI = false, bool SP2 = false>
__device__ __forceinline__ void gemm_phase(PG8_LAS unsigned char* lds, const Gemm g, const Sched& S, const Epi& E) {
    const int tid = phase_tid(), wid = __builtin_amdgcn_readfirstlane(tid >> 6), lane = tid & 63, wr = wid >> 2, wc = wid & 3, fr = lane & 15, fq = lane >> 4;
    const int K = g.K, nt = K / BK;
    unsigned voffA[2], voffB[2];
#pragma unroll
    for (int i = 0; i < 2; ++i) { int R, C; stage_rc(tid * 16 + i * 8192, R, C); const int Rb = Epi::PERM ? ((R & ~31) + perm32(R & 31)) : R;
        voffA[i] = (unsigned)(R * K + C) * 2u; voffB[i] = (unsigned)(Rb * K + C) * 2u; }
    const size_t kstep = (size_t)(BK * 2);
    const size_t hstep = (size_t)HALF * K * 2;
    const size_t tstep = 2 * hstep;
    const unsigned ldsw = (unsigned)wid * 1024u;
    const int aoff = lds_byte(wr * 64 + fr, fq * 8), boff = lds_byte(wc * 32 + fr, fq * 8);
#define PG8_SA(b, h) (((b) * 2 + (h)) * HTB)
#define PG8_SB(b, h) ((4 + (b) * 2 + (h)) * HTB)
#define PG8_STAGE(bufoff, gbase, voff) do { _Pragma("unroll") for (int _i = 0; _i < 2; ++_i) \
        __builtin_amdgcn_global_load_lds((const unsigned*)((const char*)(gbase) + (voff)[_i]), (PG8_LAS unsigned*)(lds + (bufoff) + ldsw + _i * 8192), 16, 0, 0); } while (0)
#define PG8_LDA(dst, b, h) do { _Pragma("unroll") for (int m = 0; m < 4; ++m) _Pragma("unroll") for (int k = 0; k < 2; ++k) dst[m][k] = *(const PG8_LAS bf16x8*)(lds + PG8_SA(b, h) + aoff + m * 2048 + k * 1024); } while (0)
#define PG8_LDB(dst, b, h) do { _Pragma("unroll") for (int n = 0; n < 2; ++n) _Pragma("unroll") for (int k = 0; k < 2; ++k) dst[n][k] = *(const PG8_LAS bf16x8*)(lds + PG8_SB(b, h) + boff + n * 2048 + k * 1024); } while (0)
#define PG8_MMA(ai, bj, At, Bt) do { __builtin_amdgcn_s_setprio(1); _Pragma("unroll") for (int m = 0; m < 4; ++m) _Pragma("unroll") for (int n = 0; n < 2; ++n) _Pragma("unroll") for (int k = 0; k < 2; ++k) \
        acc[ai][bj][m][n] = __builtin_amdgcn_mfma_f32_16x16x32_bf16(Bt[n][k], At[m][k], acc[ai][bj][m][n], 0, 0, 0); __builtin_amdgcn_s_setprio(0); } while (0)
#define PG8_WAIT_V(n) asm volatile("s_waitcnt vmcnt(" #n ")" ::: "memory")
#define PG8_WAIT_L(n) asm volatile("s_waitcnt lgkmcnt(" #n ")" ::: "memory")
#define PG8_BAR __builtin_amdgcn_s_barrier()
#define PG8_SCHED __builtin_amdgcn_sched_barrier(0)
    Unit cur, nxt; int ui = 0;
    if (!S.next(0, cur)) return;
    f32x4 acc[2][2][4][2];
#pragma unroll
    for (int a = 0; a < 2; ++a)
#pragma unroll
        for (int b = 0; b < 2; ++b)
#pragma unroll
            for (int m = 0; m < 4; ++m)
#pragma unroll
                for (int n = 0; n < 2; ++n) acc[a][b][m][n] = (f32x4){0.f, 0.f, 0.f, 0.f};
    bf16x8 At[4][2], B0[2][2], B1[2][2];
    const char* cA = (const char*)g.A + (size_t)cur.pm * tstep; const char* cB = (const char*)g.Bt + (size_t)cur.pn * tstep;
    S.a_ready(cur);
    if constexpr (SP2) {
        PG8_STAGE(PG8_SB(0, 0), cB, voffB); PG8_STAGE(PG8_SB(0, 1), cB + hstep, voffB); PG8_STAGE(PG8_SA(0, 0), cA, voffA); PG8_STAGE(PG8_SA(0, 1), cA + hstep, voffA);
        if (wr == 1) PG8_BAR;
        PG8_WAIT_V(2); PG8_BAR;
        PG8_STAGE(PG8_SB(1, 0), cB + kstep, voffB); PG8_STAGE(PG8_SA(1, 0), cA + kstep, voffA); PG8_STAGE(PG8_SB(1, 1), cB + hstep + kstep, voffB);
        PG8_WAIT_V(6); PG8_BAR;
    } else {
        PG8_STAGE(PG8_SB(0, 0), cB, voffB); PG8_STAGE(PG8_SA(0, 0), cA, voffA); PG8_STAGE(PG8_SB(0, 1), cB + hstep, voffB); PG8_STAGE(PG8_SA(0, 1), cA + hstep, voffA);
        if (wr == 1) PG8_BAR;
        PG8_WAIT_V(4); PG8_BAR;
        PG8_STAGE(PG8_SB(1, 0), cB + kstep, voffB); PG8_STAGE(PG8_SA(1, 0), cA + kstep, voffA); PG8_STAGE(PG8_SB(1, 1), cB + hstep + kstep, voffB);
        PG8_WAIT_V(6); PG8_BAR;
    }
    for (;;) {
        const bool has_next = S.next(ui + 1, nxt);
        const char* nA = has_next ? (const char*)g.A + (size_t)nxt.pm * tstep : cA; const char* nB = has_next ? (const char*)g.Bt + (size_t)nxt.pn * tstep : cB;
        for (int t = 0; t < nt; t += 2) {
            const bool last = (t == nt - 2);
            const char* a1 = cA + (size_t)(t + 1) * kstep;
            const char* a2 = last ? nA : cA + (size_t)(t + 2) * kstep; const char* b2 = last ? nB : cB + (size_t)(t + 2) * kstep;
            const char* a3 = a2 + kstep; const char* b3 = b2 + kstep;
            if (last && has_next) S.a_ready(nxt);
            if constexpr (SP2) {
            PG8_LDB(B0, 0, 0); PG8_LDB(B1, 0, 1); PG8_SCHED; PG8_LDA(At, 0, 0); PG8_STAGE(PG8_SA(1, 1), a1 + hstep, voffA);
            PG8_WAIT_V(8); PG8_WAIT_L(0); PG8_BAR; PG8_MMA(0, 0, At, B0); PG8_MMA(0, 1, At, B1); PG8_BAR; PG8_SCHED;
            PG8_LDA(At, 0, 1); PG8_STAGE(PG8_SB(0, 0), b2, voffB); PG8_STAGE(PG8_SB(0, 1), b2 + hstep, voffB); PG8_STAGE(PG8_SA(0, 0), a2, voffA);
            PG8_WAIT_V(8); PG8_WAIT_L(0); PG8_BAR; PG8_MMA(1, 0, At, B0); PG8_MMA(1, 1, At, B1); PG8_BAR; PG8_SCHED;
            PG8_LDB(B0, 1, 0); PG8_LDB(B1, 1, 1); PG8_SCHED; PG8_LDA(At, 1, 0); PG8_STAGE(PG8_SA(0, 1), a2 + hstep, voffA);
            PG8_WAIT_V(8); PG8_WAIT_L(0); PG8_BAR; PG8_MMA(0, 0, At, B0); PG8_MMA(0, 1, At, B1); PG8_BAR; PG8_SCHED;
            PG8_LDA(At, 1, 1); PG8_STAGE(PG8_SB(1, 0), b3, voffB); PG8_STAGE(PG8_SB(1, 1), b3 + hstep, voffB); PG8_STAGE(PG8_SA(1, 0), a3, voffA);
            PG8_WAIT_V(8); PG8_WAIT_L(0); PG8_BAR; PG8_MMA(1, 0, At, B0); PG8_MMA(1, 1, At, B1); PG8_BAR; PG8_SCHED;
            } else {
            PG8_LDB(B0, 0, 0); PG8_SCHED; PG8_LDA(At, 0, 0); PG8_STAGE(PG8_SA(1, 1), a1 + hstep, voffA);
            PG8_WAIT_L(8); PG8_BAR; PG8_WAIT_L(0); PG8_MMA(0, 0, At, B0); PG8_BAR; PG8_SCHED;
            PG8_LDB(B1, 0, 1); PG8_STAGE(PG8_SB(0, 0), b2, voffB);
            PG8_BAR; PG8_WAIT_L(0); PG8_MMA(0, 1, At, B1); PG8_BAR;
            PG8_LDA(At, 0, 1); PG8_STAGE(PG8_SA(0, 0), a2, voffA);
            PG8_BAR; PG8_WAIT_L(0); PG8_MMA(1, 0, At, B0); PG8_BAR; PG8_SCHED;
            PG8_STAGE(PG8_SB(0, 1), b2 + hstep, voffB);
            PG8_WAIT_V(6); PG8_BAR; PG8_MMA(1, 1, At, B1); PG8_BAR;
            PG8_LDB(B0, 1, 0); PG8_SCHED; PG8_LDA(At, 1, 0); PG8_STAGE(PG8_SA(0, 1), a2 + hstep, voffA);
            PG8_WAIT_L(8); PG8_BAR; PG8_WAIT_L(0); PG8_MMA(0, 0, At, B0); PG8_BAR; PG8_SCHED;
            PG8_LDB(B1, 1, 1); PG8_STAGE(PG8_SB(1, 0), b3, voffB);
            PG8_BAR; PG8_WAIT_L(0); PG8_MMA(0, 1, At, B1); PG8_BAR;
            PG8_LDA(At, 1, 1); PG8_STAGE(PG8_SA(1, 0), a3, voffA);
            PG8_BAR; PG8_WAIT_L(0); PG8_MMA(1, 0, At, B0); PG8_BAR; PG8_SCHED;
            PG8_STAGE(PG8_SB(1, 1), b3 + hstep, voffB);
            PG8_WAIT_V(6); PG8_BAR; PG8_MMA(1, 1, At, B1); PG8_BAR;
            }
        }
        if constexpr (ALIGN_EPI) { if (wr == 0) PG8_BAR; }
        if constexpr (!Epi::AFTER_DRAIN) { E(acc, cur, wr, wc, fr, fq); S.done(cur); }
        if (!has_next) break;
#pragma unroll
        for (int a = 0; a < 2; ++a)
#pragma unroll
            for (int b = 0; b < 2; ++b)
#pragma unroll
                for (int m = 0; m < 4; ++m)
#pragma unroll
                    for (int n = 0; n < 2; ++n) acc[a][b][m][n] = (f32x4){0.f, 0.f, 0.f, 0.f};
        cur = nxt; cA = nA; cB = nB; ++ui;
        if constexpr (ALIGN_EPI) { if (wr == 1) PG8_BAR; }
    }
    PG8_WAIT_V(0);
    if constexpr (!ALIGN_EPI) { if (wr == 0) PG8_BAR; }
    PG8_BAR;
    if constexpr (Epi::AFTER_DRAIN) { E.fused(acc, cur, wr, wc, fr, fq, lds, wid, lane); S.done(cur); }
#undef PG8_SA
#undef PG8_SB
#undef PG8_STAGE
#undef PG8_LDA
#undef PG8_LDB
#undef PG8_MMA
#undef PG8_WAIT_V
#undef PG8_WAIT_L
#undef PG8_BAR
#undef PG8_SCHED
}
}
#define LAS __attribute__((address_space(3)))
typedef unsigned short bf16_t;
typedef short bf16x8 __attribute__((ext_vector_type(8)));
typedef float f32x4 __attribute__((ext_vector_type(4)));
typedef unsigned u32x4 __attribute__((ext_vector_type(4)));
typedef unsigned u32x2 __attribute__((ext_vector_type(2)));
constexpr size_t MiB = 1u << 20;
constexpr size_t WS_CTL = 0, WS_COND = 1 * MiB, WS_QB = 1 * MiB + 65536, WS_BIAS1 = 1 * MiB + 98304, WS_PART = 2 * MiB;
constexpr size_t WS_BT1 = 4 * MiB, WS_BT2 = 8 * MiB, WS_BT3 = 10 * MiB, WS_KEYS = 14 * MiB, WS_WSB = 14 * MiB + 524288;
constexpr size_t WS_UFP8 = 16 * MiB, WS_VFP8 = 32 * MiB, WS_HB = 48 * MiB  , WS_YCAT = 80 * MiB, WS_AGLU = 112 * MiB, WS_UG = 128 * MiB, WS_VG = 144 * MiB;
constexpr size_t WS_X1B = 112 * MiB;
constexpr size_t WS_Q = 160 * MiB, WS_EIDX = 240 * MiB, WS_GATE = 248 * MiB;

struct Params {
    const float* in[23];
    float* out;
    unsigned char* ws;
};
enum { I_X = 0, I_C, I_WADA, I_BADA, I_G1, I_WIN, I_BIN, I_CONVW, I_CONVB, I_GCLN, I_BCLN, I_GVLN, I_BVLN, I_WSP, I_BSP, I_WOUT, I_BOUT, I_G2, I_WQ, I_KEYS, I_EU, I_EV, I_GF };

__device__ __forceinline__ unsigned pk_bf16(float lo, float hi) { unsigned r; asm volatile("v_cvt_pk_bf16_f32 %0, %1, %2" : "=v"(r) : "v"(lo), "v"(hi)); return r; }
__device__ __forceinline__ float bf_lo(unsigned w) { return __uint_as_float(w << 16); }
__device__ __forceinline__ float bf_hi(unsigned w) { return __uint_as_float(w & 0xffff0000u); }

typedef float f32x16 __attribute__((ext_vector_type(16)));
typedef float f32x32 __attribute__((ext_vector_type(32)));
typedef unsigned u32x6 __attribute__((ext_vector_type(6)));
#ifndef FMT_U
#define FMT_U 4
#endif
#ifndef FMT_V
#define FMT_V 4
#endif
template <int FMT> struct RowFmt { static constexpr int LB = FMT == 6 ? 24 : 16, RSB = FMT == 6 ? 768 : 512; };
constexpr size_t WS_SU = 1 * MiB + 262144, WS_SV = 1 * MiB + 262144 + 65536;
constexpr size_t WS_USC = 24 * MiB, WS_VSC = 40 * MiB;
__device__ __forceinline__ float half_max(float v) {
    v = fmaxf(v, SWZ(v, 0x401F)); v = fmaxf(v, SWZ(v, 0x201F)); v = fmaxf(v, SWZ(v, 0x101F)); v = fmaxf(v, SWZ(v, 0x081F)); v = fmaxf(v, SWZ(v, 0x041F)); return v;
}
template <int FMT> __device__ __forceinline__ void convert_row_from(const float4 (&xl)[8], unsigned char* __restrict__ dst, float* __restrict__ side, int l32);
template <int FMT> __device__ __forceinline__ void convert_row(const float* __restrict__ src, unsigned char* __restrict__ dst, float* __restrict__ side, int l32) {
    float4 xl[8];
#pragma unroll
    for (int j = 0; j < 8; ++j) xl[j] = *(const float4*)(src + 128 * j + 4 * l32);
    __builtin_amdgcn_sched_barrier(0);
    convert_row_from<FMT>(xl, dst, side, l32);
}
template <int FMT> __device__ __forceinline__ void convert_row_from(const float4 (&xl)[8], unsigned char* __restrict__ dst, float* __restrict__ side, int l32) {
    float v[32]; float am = 0.f;
#pragma unroll
    for (int j = 0; j < 8; ++j) { const float4 x = xl[j]; v[4 * j] = x.x; v[4 * j + 1] = x.y; v[4 * j + 2] = x.z; v[4 * j + 3] = x.w;
        am = fmaxf(am, fmaxf(fmaxf(fabsf(x.x), fabsf(x.y)), fmaxf(fabsf(x.z), fabsf(x.w)))); }
    if constexpr (FMT == 6) {
        am = half_max(am);
        const float s = fmaxf(am, 1e-30f) * (1.f / 7.5f), inv = 1.f / s;
        f32x16 a, b;
#pragma unroll
        for (int m = 0; m < 16; ++m) { a[m] = v[m] * inv; b[m] = v[16 + m] * inv; }
        const u32x6 w = __builtin_amdgcn_cvt_scalef32_2xpk16_fp6_f32(a, b, 1.0f);
        u32x4 w0; w0.x = w[0]; w0.y = w[1]; w0.z = w[2]; w0.w = w[3]; u32x2 w1; w1.x = w[4]; w1.y = w[5];
        *(u32x4*)(dst + 24 * l32) = w0; *(u32x2*)(dst + 24 * l32 + 16) = w1;
        if (l32 == 0) *side = s;
    } else {
        const unsigned sb = pk_bf16(fmaxf(am, 1e-30f) * (1.f / 6.f), 0.f) & 0xffffu;
        const float s = __uint_as_float(sb << 16), inv = 1.f / s;
        u32x4 w; unsigned* wp = (unsigned*)&w;
#pragma unroll
        for (int d = 0; d < 4; ++d) { unsigned x = 0u;
            x = __builtin_amdgcn_cvt_scalef32_pk_fp4_f32(x, v[8 * d + 0] * inv, v[8 * d + 1] * inv, 1.0f, 0);
            x = __builtin_amdgcn_cvt_scalef32_pk_fp4_f32(x, v[8 * d + 2] * inv, v[8 * d + 3] * inv, 1.0f, 1);
            x = __builtin_amdgcn_cvt_scalef32_pk_fp4_f32(x, v[8 * d + 4] * inv, v[8 * d + 5] * inv, 1.0f, 2);
            x = __builtin_amdgcn_cvt_scalef32_pk_fp4_f32(x, v[8 * d + 6] * inv, v[8 * d + 7] * inv, 1.0f, 3);
            wp[d] = x; }
        *(u32x4*)(dst + 16 * l32) = w;
        ((unsigned short*)side)[l32] = (unsigned short)sb;
    }
}
template <int FMT> struct RowData;
template <> struct RowData<6> { u32x4 a; u32x2 b; };
template <> struct RowData<4> { u32x4 a; unsigned short sc; };
template <int FMT> __device__ __forceinline__ RowData<FMT> row_load(const unsigned char* p  , const unsigned char* psc  ) {
    RowData<FMT> r;
    if constexpr (FMT == 6) { r.a = *(const u32x4*)p; r.b = *(const u32x2*)(p + 16); }
    else { r.a = *(const u32x4*)p; r.sc = *(const unsigned short*)psc; }
    return r;
}
template <int FMT> __device__ __forceinline__ void row_decode(const RowData<FMT>& r, f32x2 (&o)[16], float& bscale) {
    if constexpr (FMT == 6) {
        u32x6 w; w[0] = r.a.x; w[1] = r.a.y; w[2] = r.a.z; w[3] = r.a.w; w[4] = r.b.x; w[5] = r.b.y;
        const f32x32 f = __builtin_amdgcn_cvt_scalef32_pk32_f32_fp6(w, 1.0f);
#pragma unroll
        for (int m = 0; m < 16; ++m) o[m] = (f32x2){f[2 * m], f[2 * m + 1]};
        bscale = 1.f;
    } else {
        const unsigned* wp = (const unsigned*)&r.a;
#pragma unroll
        for (int d = 0; d < 4; ++d) { o[4 * d + 0] = __builtin_amdgcn_cvt_scalef32_pk_f32_fp4(wp[d], 1.0f, 0); o[4 * d + 1] = __builtin_amdgcn_cvt_scalef32_pk_f32_fp4(wp[d], 1.0f, 1);
            o[4 * d + 2] = __builtin_amdgcn_cvt_scalef32_pk_f32_fp4(wp[d], 1.0f, 2); o[4 * d + 3] = __builtin_amdgcn_cvt_scalef32_pk_f32_fp4(wp[d], 1.0f, 3); }
        bscale = __uint_as_float((unsigned)r.sc << 16);
    }
}
__device__ __forceinline__ float reduce8_half(const float (&s)[8], int lane) {
    const bool b4 = lane & 16, b3 = lane & 8, b2 = lane & 4;
    float u[4];
#pragma unroll
    for (int k = 0; k < 4; ++k) { const float keep = b4 ? s[k + 4] : s[k], send = b4 ? s[k] : s[k + 4]; u[k] = keep + SWZ(send, 0x401F); }
    float v[2];
#pragma unroll
    for (int k = 0; k < 2; ++k) { const float keep = b3 ? u[k + 2] : u[k], send = b3 ? u[k] : u[k + 2]; v[k] = keep + SWZ(send, 0x201F); }
    const float keep = b2 ? v[1] : v[0], send = b2 ? v[0] : v[1];
    float w = keep + SWZ(send, 0x101F);
    w += SWZ(w, 0x081F); w += SWZ(w, 0x041F);
    return w;
}
typedef int i32x8 __attribute__((ext_vector_type(8)));
typedef _Float16 h16x2 __attribute__((ext_vector_type(2)));
__device__ __forceinline__ void convert_row_umx_from(const float4 (&xl)[8], unsigned char* __restrict__ dst, unsigned char* __restrict__ sdst, int l32);
__device__ __forceinline__ void convert_row_umx(const float* __restrict__ src, unsigned char* __restrict__ dst, unsigned char* __restrict__ sdst, int l32) {
    float4 xl[8];
#pragma unroll
    for (int j = 0; j < 8; ++j) xl[j] = *(const float4*)(src + 32 * l32 + 4 * j);
    __builtin_amdgcn_sched_barrier(0);
    convert_row_umx_from(xl, dst, sdst, l32);
}
__device__ __forceinline__ void convert_row_umx_from(const float4 (&xl)[8], unsigned char* __restrict__ dst, unsigned char* __restrict__ sdst, int l32) {
    float v[32]; float am = 0.f;
#pragma unroll
    for (int j = 0; j < 8; ++j) { v[4 * j] = xl[j].x; v[4 * j + 1] = xl[j].y; v[4 * j + 2] = xl[j].z; v[4 * j + 3] = xl[j].w;
        am = fmaxf(am, fmaxf(fmaxf(fabsf(xl[j].x), fabsf(xl[j].y)), fmaxf(fabsf(xl[j].z), fabsf(xl[j].w)))); }
    am = fmaxf(am, 1e-30f);
    const int bits = __float_as_int(am * (1.f / 6.f));
    const int e_up = ((bits >> 23) & 255) - 127 + ((bits & 0x7fffff) ? 1 : 0);
    const float s_dn = __int_as_float((e_up - 1 + 127) << 23);
    int e = (am <= 7.f * s_dn) ? e_up - 1 : e_up;
    e = e < -120 ? -120 : (e > 120 ? 120 : e);
    const float inv = __int_as_float((127 - e) << 23);
    u32x4 w; unsigned* wp = (unsigned*)&w;
#pragma unroll
    for (int d = 0; d < 4; ++d) { unsigned x = 0u;
        x = __builtin_amdgcn_cvt_scalef32_pk_fp4_f32(x, v[8 * d + 0] * inv, v[8 * d + 1] * inv, 1.0f, 0);
        x = __builtin_amdgcn_cvt_scalef32_pk_fp4_f32(x, v[8 * d + 2] * inv, v[8 * d + 3] * inv, 1.0f, 1);
        x = __builtin_amdgcn_cvt_scalef32_pk_fp4_f32(x, v[8 * d + 4] * inv, v[8 * d + 5] * inv, 1.0f, 2);
        x = __builtin_amdgcn_cvt_scalef32_pk_fp4_f32(x, v[8 * d + 6] * inv, v[8 * d + 7] * inv, 1.0f, 3);
        wp[d] = x; }
    *(u32x4*)(dst + 16 * l32) = w;
    sdst[8 * (l32 & 3) + (l32 >> 2)] = (unsigned char)(e + 127);
}

__device__ __forceinline__ void peer_sort_pairs(int& eX, int& eY, float& gX, float& gY, bool desc, LAS unsigned char* scr, int lane) {
    const int bx = eX >> 10, by = eY >> 10;
    int base = 0, posX = 0, posY = 0;
#pragma nounroll
    for (int b = 0; b < 16; ++b) {
        const unsigned long long balX = __ballot(bx == b), balY = __ballot(by == b);
        const int cX = __popcll(balX), cY = __popcll(balY);
        const int mX = __builtin_amdgcn_mbcnt_hi((unsigned)(balX >> 32), __builtin_amdgcn_mbcnt_lo((unsigned)balX, 0u)), mY = __builtin_amdgcn_mbcnt_hi((unsigned)(balY >> 32), __builtin_amdgcn_mbcnt_lo((unsigned)balY, 0u));
        posX = bx == b ? base + mX : posX; posY = by == b ? base + cX + mY : posY;
        base += cX + cY;
    }
    if (desc) { posX = 127 - posX; posY = 127 - posY; }
    u32x2 wX; wX.x = (unsigned)eX; wX.y = __float_as_uint(gX); u32x2 wY; wY.x = (unsigned)eY; wY.y = __float_as_uint(gY);
    *(LAS u32x2*)(scr + 8 * posX) = wX; *(LAS u32x2*)(scr + 8 * posY) = wY;
    asm volatile("s_waitcnt lgkmcnt(0)" ::: "memory");
    const u32x2 rX = *(const LAS u32x2*)(scr + 8 * lane), rY = *(const LAS u32x2*)(scr + 8 * (64 + lane));
    asm volatile("s_waitcnt lgkmcnt(0)" ::: "memory");
    eX = (int)rX.x; gX = __uint_as_float(rX.y); eY = (int)rY.x; gY = __uint_as_float(rY.y);
}
constexpr int PEER_LDS_TAB = 7168 * 4;
constexpr int PEER_HS = 2080 + 4096 + 1024;
template <int PMODE> __device__ __forceinline__ void phase_peer(const Params& P, float* ldsf, int bid, int nblk, float* xout) {
    constexpr int LBV = RowFmt<FMT_V>::LB, RSV = RowFmt<FMT_V>::RSB, RSU = 512;
    const unsigned char* usct = P.ws + WS_USC; const unsigned char* vsct = P.ws + WS_VSC;
    const float* cond = (const float*)(P.ws + WS_COND); const float* part = (const float*)(P.ws + WS_PART);
    const int* eidx = (const int*)(P.ws + WS_EIDX); const float* gate = (const float*)(P.ws + WS_GATE);
    const unsigned char* utab = P.ws + WS_UFP8; const unsigned char* vtab = P.ws + WS_VFP8;
    float* xio = P.out;
    const int tid = phase_tid(), lane = tid & 63, wave = tid >> 6, l32 = lane & 31, hf = lane >> 5, li = lane & 15, lg = lane >> 4;
    float* G2 = ldsf; float* SH2 = ldsf + 2048; float* GT2 = ldsf + 4096; float* GF = ldsf + 6144;
    LAS unsigned char* hs = (LAS unsigned char*)ldsf + PEER_LDS_TAB + wave * PEER_HS;
    for (int i = tid; i < 2048; i += 512) { const int b = i >> 10, d = i & 1023;
        G2[i] = P.in[I_G2][d] * (1.f + cond[b * 6 * D + 4 * D + d]); SH2[i] = cond[b * 6 * D + 3 * D + d]; GT2[i] = cond[b * 6 * D + 5 * D + d]; }
    for (int i = tid; i < 1024; i += 512) GF[i] = P.in[I_GF][i];
    if (lane < 8) *(LAS unsigned*)(hs + 2048 + 4 * lane) = 0u;
    __syncthreads();
    const int hb_base = li < 2 ? (li * 1024 + 16 * lg) : 2048, hb_step = li < 2 ? 128 : 0, hb_hi = li < 2 ? 64 : 16;
    const int sbv = 127;
    u32x4 ub[8]; u32x2 usc; RowData<FMT_V> vb[2][8];
    int t = bid * 8 + wave;
    int eA = 0, eB = 0; float gA = 0.f, gB = 0.f;
    int eAn = 0, eBn = 0; float gAn = 0.f, gBn = 0.f;
    if (t < T) { eA = eidx[(size_t)t * 128 + lane]; eB = eidx[(size_t)t * 128 + 64 + lane]; gA = gate[(size_t)t * 128 + lane]; gB = gate[(size_t)t * 128 + 64 + lane];
        const int t1 = (t + nblk * 8 < T) ? t + nblk * 8 : t;
        eAn = eidx[(size_t)t1 * 128 + lane]; eBn = eidx[(size_t)t1 * 128 + 64 + lane]; gAn = gate[(size_t)t1 * 128 + lane]; gBn = gate[(size_t)t1 * 128 + 64 + lane];
        peer_sort_pairs(eA, eB, gA, gB, false, hs + 2080 + 4096, lane); }
    int tk = 0;
#define PEER_ISSUE_U(eS_, gg) do { const int el_ = __builtin_amdgcn_ds_bpermute(((((gg) & 3) << 4) + li) << 2, eS_); \
            const unsigned char* rb_ = utab + (size_t)el_ * RSU; \
            _Pragma("unroll") for (int c = 0; c < 8; ++c) ub[c] = *(const u32x4*)(rb_ + 16 * lg + 64 * c); usc = *(const u32x2*)(usct + (size_t)el_ * 32 + 8 * lg); } while (0)
#define PEER_ISSUE_V1(bf, eS_, gg, p) do { const int l0_ = ((gg) & 3) << 4; \
            const int e0_ = __builtin_amdgcn_readlane(eS_, l0_ + 2 * (p)), e1_ = __builtin_amdgcn_readlane(eS_, l0_ + 2 * (p) + 1); \
            const int ev_ = hf ? e1_ : e0_; vb[bf][p] = row_load<FMT_V>(vtab + (size_t)ev_ * RSV + LBV * l32, vsct + (size_t)ev_ * 64 + 2 * l32); } while (0)
    if (t < T) {
        PEER_ISSUE_U(eA, 0);
#pragma unroll
        for (int p = 0; p < 8; ++p) PEER_ISSUE_V1(0, eA, 0, p);
#pragma unroll
        for (int p = 0; p < 8; ++p) PEER_ISSUE_V1(1, eA, 1, p); }
    for (; t < T; t += nblk * 8) {
        const int b = t >> 13;
        const bf16_t* xrow = (const bf16_t*)(P.ws + WS_X1B) + (size_t)t * D;
        peer_sort_pairs(eAn, eBn, gAn, gBn, ((tk + 1) & 1) != 0, hs + 2080 + 4096, lane);
        const int tn = (t + 2 * nblk * 8 < T) ? t + 2 * nblk * 8 : t;
        const int eAnn = __builtin_nontemporal_load(eidx + (size_t)tn * 128 + lane), eBnn = __builtin_nontemporal_load(eidx + (size_t)tn * 128 + 64 + lane); const float gAnn = __builtin_nontemporal_load(gate + (size_t)tn * 128 + lane), gBnn = __builtin_nontemporal_load(gate + (size_t)tn * 128 + 64 + lane);
        const float4* pp = (const float4*)(part + (size_t)t * 16);
        const float4 q0 = pp[0], q1 = pp[1], q2 = pp[2], q3 = pp[3];
        float4 xl[4];
#pragma unroll
        for (int j = 0; j < 2; ++j) { const u32x4 xv_ = __builtin_nontemporal_load((const u32x4*)(xrow + 16 * lane + 8 * j));
            xl[2 * j].x = bf_lo(xv_.x); xl[2 * j].y = bf_hi(xv_.x); xl[2 * j].z = bf_lo(xv_.y); xl[2 * j].w = bf_hi(xv_.y); xl[2 * j + 1].x = bf_lo(xv_.z); xl[2 * j + 1].y = bf_hi(xv_.z); xl[2 * j + 1].z = bf_lo(xv_.w); xl[2 * j + 1].w = bf_hi(xv_.w); }
        __builtin_amdgcn_sched_barrier(0);
        const float ss = (((q0.x + q0.y) + (q0.z + q0.w)) + ((q1.x + q1.y) + (q1.z + q1.w))) + (((q2.x + q2.y) + (q2.z + q2.w)) + ((q3.x + q3.y) + (q3.z + q3.w)));
        const float r = rsqrtf(ss * (1.f / D) + EPS);
        {
            u32x4 whi, wlo; unsigned* ph = (unsigned*)&whi; unsigned* pl = (unsigned*)&wlo;
#pragma unroll
            for (int j = 0; j < 4; ++j) { const float4 g4 = *(const float4*)(G2 + b * 1024 + 16 * lane + 4 * j), s4 = *(const float4*)(SH2 + b * 1024 + 16 * lane + 4 * j);
                const float h0 = xl[j].x * r * g4.x + s4.x, h1 = xl[j].y * r * g4.y + s4.y, h2v = xl[j].z * r * g4.z + s4.z, h3 = xl[j].w * r * g4.w + s4.w;
                int wh = 0; wh = __builtin_amdgcn_cvt_pk_fp8_f32(h0, h1, wh, false); wh = __builtin_amdgcn_cvt_pk_fp8_f32(h2v, h3, wh, true);
                const f32x2 d01 = __builtin_amdgcn_cvt_pk_f32_fp8(wh, false), d23 = __builtin_amdgcn_cvt_pk_f32_fp8(wh, true);
                int wl = 0; wl = __builtin_amdgcn_cvt_pk_fp8_f32((h0 - d01.x), (h1 - d01.y), wl, false); wl = __builtin_amdgcn_cvt_pk_fp8_f32((h2v - d23.x), (h3 - d23.y), wl, true);
                ph[j] = (unsigned)wh; pl[j] = (unsigned)wl; }
            *(LAS u32x4*)(hs + 16 * lane) = whi; *(LAS u32x4*)(hs + 1024 + 16 * lane) = wlo;
#pragma unroll
            for (int j = 0; j < 4; ++j) *(LAS f32x4*)(hs + 2080 + 4 * (16 * lane + 4 * j)) = (f32x4){xl[j].x, xl[j].y, xl[j].z, xl[j].w};
        }
        asm volatile("s_waitcnt lgkmcnt(0)" ::: "memory");
        h16x2 o[16];
#pragma unroll
        for (int m = 0; m < 16; ++m) o[m] = (h16x2){(_Float16)0.f, (_Float16)0.f};
#pragma unroll
        for (int g = 0; g < 8; ++g) {
            constexpr int dummy_ = 0; (void)dummy_;
            const int bf = g & 1;
            f32x4 acc = {0.f, 0.f, 0.f, 0.f};
#pragma unroll
            for (int hh = 0; hh < 2; ++hh) {
                i32x8 hB[4];
#pragma unroll
                for (int c4 = 0; c4 < 4; ++c4) { const int c = 4 * hh + c4; const u32x4 lo4 = *(const LAS u32x4*)(hs + hb_base + c * hb_step), hi4 = *(const LAS u32x4*)(hs + hb_base + c * hb_step + hb_hi);
                    hB[c4][0] = lo4.x; hB[c4][1] = lo4.y; hB[c4][2] = lo4.z; hB[c4][3] = lo4.w; hB[c4][4] = hi4.x; hB[c4][5] = hi4.y; hB[c4][6] = hi4.z; hB[c4][7] = hi4.w; }
#pragma unroll
                for (int c4 = 0; c4 < 4; ++c4) { const int c = 4 * hh + c4; i32x8 a8; a8[0] = (int)ub[c].x; a8[1] = (int)ub[c].y; a8[2] = (int)ub[c].z; a8[3] = (int)ub[c].w; a8[4] = 0; a8[5] = 0; a8[6] = 0; a8[7] = 0;
                    const int sa = (int)(hh == 0 ? usc.x : usc.y);
                    switch (c4) {
                        case 0: acc = __builtin_amdgcn_mfma_scale_f32_16x16x128_f8f6f4(a8, hB[c4], acc, 4, 0, 0, sa, 0, sbv); break;
                        case 1: acc = __builtin_amdgcn_mfma_scale_f32_16x16x128_f8f6f4(a8, hB[c4], acc, 4, 0, 1, sa, 0, sbv); break;
                        case 2: acc = __builtin_amdgcn_mfma_scale_f32_16x16x128_f8f6f4(a8, hB[c4], acc, 4, 0, 2, sa, 0, sbv); break;
                        default: acc = __builtin_amdgcn_mfma_scale_f32_16x16x128_f8f6f4(a8, hB[c4], acc, 4, 0, 3, sa, 0, sbv); break; } }
            }
            __builtin_amdgcn_sched_barrier(0);
            if (g < 7) PEER_ISSUE_U(((g + 1) & 4) ? eB : eA, g + 1); else PEER_ISSUE_U(eAn, 0);
            __builtin_amdgcn_sched_barrier(0);
            float act[4];
#pragma unroll
            for (int rr = 0; rr < 4; ++rr) { const float dsum = acc[rr] + SWZ(acc[rr], 0x041F);
                const float gq = __int_as_float(__builtin_amdgcn_ds_bpermute((((g & 3) << 4) + 4 * lg + rr) << 2, __float_as_int((g & 4) ? gB : gA)));
                act[rr] = gelu_fast(dsum) * gq; }
#pragma unroll
            for (int p = 0; p < 8; ++p) {
                h16x2 dv[16]; const unsigned* wp = (const unsigned*)&vb[bf][p].a;
#pragma unroll
                for (int d = 0; d < 4; ++d) { dv[4 * d + 0] = __builtin_amdgcn_cvt_scalef32_pk_f16_fp4(wp[d], 1.0f, 0); dv[4 * d + 1] = __builtin_amdgcn_cvt_scalef32_pk_f16_fp4(wp[d], 1.0f, 1);
                    dv[4 * d + 2] = __builtin_amdgcn_cvt_scalef32_pk_f16_fp4(wp[d], 1.0f, 2); dv[4 * d + 3] = __builtin_amdgcn_cvt_scalef32_pk_f16_fp4(wp[d], 1.0f, 3); }
                const float bs = __uint_as_float((unsigned)vb[bf][p].sc << 16);
                const float a0 = __int_as_float(__builtin_amdgcn_readlane(__float_as_int(act[(2 * p) & 3]), 16 * ((2 * p) >> 2))), a1 = __int_as_float(__builtin_amdgcn_readlane(__float_as_int(act[(2 * p + 1) & 3]), 16 * ((2 * p + 1) >> 2)));
                const _Float16 ah = (_Float16)((hf ? a1 : a0) * bs); const h16x2 aa = {ah, ah};
                __builtin_amdgcn_sched_barrier(0);
                if (g < 6) PEER_ISSUE_V1(bf, ((g + 2) & 4) ? eB : eA, g + 2, p); else PEER_ISSUE_V1(bf, eAn, g - 6, p);
                __builtin_amdgcn_sched_barrier(0);
#pragma unroll
                for (int m = 0; m < 16; ++m) o[m] = __builtin_elementwise_fma(dv[m], aa, o[m]); }
            __builtin_amdgcn_sched_barrier(0);
        }

        float sq = 0.f; float4 xr[8];
#pragma unroll
        for (int j = 0; j < 8; ++j) { const f32x4 xv_ = *(const LAS f32x4*)(hs + 2080 + 4 * (128 * j + 4 * l32)); xr[j].x = xv_[0]; xr[j].y = xv_[1]; xr[j].z = xv_[2]; xr[j].w = xv_[3]; }
        __builtin_amdgcn_sched_barrier(0);
#pragma unroll
        for (int j = 0; j < 8; ++j) { const float4 g4 = *(const float4*)(GT2 + b * 1024 + 128 * j + 4 * l32);
            float ov[4] = {(float)o[2 * j].x, (float)o[2 * j].y, (float)o[2 * j + 1].x, (float)o[2 * j + 1].y};
#pragma unroll
            for (int i = 0; i < 4; ++i) { auto rr = __builtin_amdgcn_permlane32_swap(__float_as_uint(ov[i]), __float_as_uint(ov[i]), false, false); ov[i] = __uint_as_float(rr[0]) + __uint_as_float(rr[1]); }
            xr[j].x += g4.x * ov[0]; xr[j].y += g4.y * ov[1]; xr[j].z += g4.z * ov[2]; xr[j].w += g4.w * ov[3];
            sq += (xr[j].x * xr[j].x + xr[j].y * xr[j].y) + (xr[j].z * xr[j].z + xr[j].w * xr[j].w); }
        sq += SWZ(sq, 0x401F); sq += SWZ(sq, 0x201F); sq += SWZ(sq, 0x101F); sq += SWZ(sq, 0x081F); sq += SWZ(sq, 0x041F);
        const float rr = rsqrtf(sq * (1.f / D) + EPS);
#pragma unroll
        for (int j = 0; j < 8; ++j) if ((j >> 2) == hf) { const float4 g4 = *(const float4*)(GF + 128 * j + 4 * l32);
            float4 ov; ov.x = xr[j].x * rr * g4.x; ov.y = xr[j].y * rr * g4.y; ov.z = xr[j].z * rr * g4.z; ov.w = xr[j].w * rr * g4.w;
            __builtin_nontemporal_store((f32x4){ov.x, ov.y, ov.z, ov.w}, (f32x4*)(xout + (size_t)t * D + 128 * j + 4 * l32)); }
        eA = eAn; eB = eBn; gA = gAn; gB = gBn; eAn = eAnn; eBn = eBnn; gAn = gAnn; gBn = gBnn; ++tk;
    }
#undef PEER_ISSUE_U
#undef PEER_ISSUE_V1
}

__device__ __forceinline__ int inproj_row(int n) {
    const int sec = n >> 9, m = n & 511;
    return (sec >> 1) * 1024 + (m >> 7) * 256 + (sec & 1) * 128 + (m & 127);
}
template <int MODE> __device__ __forceinline__ void transpose_tile(const float* __restrict__ W, int K, int N, bf16_t* __restrict__ Bt, int k0, int n0, float* tile  ) {
    const int tid = threadIdx.x;
#pragma unroll
    for (int p = 0; p < 2; ++p) { const int kk = p * 32 + (tid >> 4), nn = (tid & 15) * 4;
        const float4 v = *(const float4*)(W + (size_t)(k0 + kk) * N + n0 + nn);
        tile[kk * 65 + nn] = v.x; tile[kk * 65 + nn + 1] = v.y; tile[kk * 65 + nn + 2] = v.z; tile[kk * 65 + nn + 3] = v.w; }
    __syncthreads();
    { const int n = tid >> 3, kc = (tid & 7) * 8; const float* s = tile + kc * 65 + n;
      u32x4 o; o.x = pk_bf16(s[0], s[65]); o.y = pk_bf16(s[2 * 65], s[3 * 65]); o.z = pk_bf16(s[4 * 65], s[5 * 65]); o.w = pk_bf16(s[6 * 65], s[7 * 65]);
      const int row = MODE == 1 ? inproj_row(n0 + n) : (n0 + n);
      *(u32x4*)(Bt + (size_t)row * K + k0 + kc) = o; }
    __syncthreads();
}
__device__ __forceinline__ void phase0(const Params& P, float* ldsf, int bid, int nblk) {
    const int tid = phase_tid(), lane = tid & 63, wave = tid >> 6;
    unsigned char* ws = P.ws;
    for (int citem = bid; citem < 192; citem += nblk) {
        float* sl = ldsf;
        float* red = ldsf + 2048;
        for (int i = tid; i < 2048; i += 512) { const float cv = P.in[I_C][i]; sl[i] = cv * __builtin_amdgcn_rcpf(1.f + __builtin_amdgcn_exp2f(-1.4426950408889634f * cv)); }
        __syncthreads();
        const int c = tid & 31, kp = tid >> 5, n = citem * 32 + c;
        float a0 = 0.f, a1 = 0.f;
        const float* wp = P.in[I_WADA] + (size_t)(kp * 64) * 6144 + n;
#pragma unroll 8
        for (int k = 0; k < 64; ++k) { const float w = wp[(size_t)k * 6144]; a0 += sl[kp * 64 + k] * w; a1 += sl[1024 + kp * 64 + k] * w; }
        red[kp * 32 + c] = a0; red[512 + kp * 32 + c] = a1;
        __syncthreads();
        if (tid < 64) { const int b = tid >> 5, cc = tid & 31; float s = 0.f;
#pragma unroll
            for (int j = 0; j < 16; ++j) s += red[b * 512 + j * 32 + cc];
            ((float*)(ws + WS_COND))[b * 6144 + citem * 32 + cc] = s + P.in[I_BADA][citem * 32 + cc]; }
        __syncthreads();
    }
    for (int it = bid; it < 1280; it += nblk) {
        if (it < 512) transpose_tile<1>(P.in[I_WIN], 1024, 2048, (bf16_t*)(ws + WS_BT1), (it >> 5) * 64, (it & 31) * 64, ldsf);
        else if (it < 768) { const int r = it - 512; transpose_tile<0>(P.in[I_WOUT], 1024, 1024, (bf16_t*)(ws + WS_BT2), (r >> 4) * 64, (r & 15) * 64, ldsf); }
        else { const int r = it - 768; transpose_tile<0>(P.in[I_WQ], 1024, 2048, (bf16_t*)(ws + WS_BT3), (r >> 5) * 64, (r & 31) * 64, ldsf); }
    }
    const int gt = bid * 512 + tid, ngt = nblk * 512;
    for (int i = gt; i < 2048; i += ngt) ((float*)(ws + WS_BIAS1))[inproj_row(i)] = P.in[I_BIN][i];
    for (int i = gt; i < 8 * 2 * 128 * 128 / 4; i += ngt) { const float4 v = *(const float4*)(P.in[I_KEYS] + (size_t)i * 4); u32x2 o; o.x = pk_bf16(v.x, v.y); o.y = pk_bf16(v.z, v.w); *(u32x2*)((bf16_t*)(ws + WS_KEYS) + (size_t)i * 4) = o; }
    for (int i = gt; i < 8 * 128 * 128 / 4; i += ngt) { const int e = i * 4, s = e & 127, t = (e >> 7) & 127; float4 v = *(const float4*)(P.in[I_WSP] + (size_t)e);
        v.x = (s + 0 <= t) ? v.x : 0.f; v.y = (s + 1 <= t) ? v.y : 0.f; v.z = (s + 2 <= t) ? v.z : 0.f; v.w = (s + 3 <= t) ? v.w : 0.f;
        u32x2 o; o.x = pk_bf16(v.x, v.y); o.y = pk_bf16(v.z, v.w); *(u32x2*)((bf16_t*)(ws + WS_WSB) + (size_t)e) = o; }
    if (nblk != 256) { const int l32 = lane & 31, hf = lane >> 5;
      for (int r2 = bid * 8 + wave; r2 < NEXP / 2; r2 += nblk * 8) { const int r = 2 * r2 + hf;
          convert_row_umx(P.in[I_EU] + (size_t)r * D, ws + WS_UFP8 + (size_t)r * 512, ws + WS_USC + (size_t)r * 32, l32);
          convert_row<FMT_V>(P.in[I_EV] + (size_t)r * D, ws + WS_VFP8 + (size_t)r * RowFmt<FMT_V>::RSB, (float*)(ws + WS_VSC + (size_t)r * 64), l32); } }
}
__device__ __forceinline__ void phase0b(const Params& P, float* ldsf, int bid, int nblk) {
    const int tid = phase_tid(), lane = tid & 63, wave = tid >> 6;
    unsigned char* ws = P.ws; const float* cond = (const float*)(ws + WS_COND);
    float* G1 = ldsf; float* SH1 = ldsf + 2048;
    for (int i = tid; i < 2048; i += 512) { const int b = i >> 10, d = i & 1023; G1[i] = P.in[I_G1][d] * (1.f + cond[b * 6144 + 1024 + d]); SH1[i] = cond[b * 6144 + d]; }
    __syncthreads();
    {
        for (int n = bid * 8 + wave; n < 2048; n += nblk * 8) {
            const bf16_t* brow = (const bf16_t*)(ws + WS_BT3) + (size_t)n * 1024;
            float a0 = 0.f, a1 = 0.f;
#pragma unroll
            for (int j = 0; j < 2; ++j) { const u32x4 w = *(const u32x4*)(brow + j * 512 + lane * 8); const int k = j * 512 + lane * 8;
                const float wv[8] = {bf_lo(w.x), bf_hi(w.x), bf_lo(w.y), bf_hi(w.y), bf_lo(w.z), bf_hi(w.z), bf_lo(w.w), bf_hi(w.w)};
#pragma unroll
                for (int e = 0; e < 8; ++e) { a0 += wv[e] * cond[3 * 1024 + k + e]; a1 += wv[e] * cond[6144 + 3 * 1024 + k + e]; } }
            a0 = wave_sum(a0); a1 = wave_sum(a1);
            if (lane == 0) { ((float*)(ws + WS_QB))[n] = a0; ((float*)(ws + WS_QB))[2048 + n] = a1; }
        }
    }
    const float* x = P.in[I_X]; bf16_t* hb = (bf16_t*)(ws + WS_HB);
    for (int t = bid * 8 + wave; t < T; t += nblk * 8) {
        const int b = t >> 13;
        float4 v[4]; float s = 0.f;
#pragma unroll
        for (int j = 0; j < 4; ++j) { v[j] = *(const float4*)(x + (size_t)t * D + 256 * j + 4 * lane); s += (v[j].x * v[j].x + v[j].y * v[j].y) + (v[j].z * v[j].z + v[j].w * v[j].w); }
        s = wave_sum(s);
        const float r = rsqrtf(s * (1.f / D) + EPS);
#pragma unroll
        for (int j = 0; j < 4; ++j) { const float4 g4 = *(const float4*)(G1 + b * 1024 + 256 * j + 4 * lane), s4 = *(const float4*)(SH1 + b * 1024 + 256 * j + 4 * lane);
            u32x2 o; o.x = pk_bf16(v[j].x * r * g4.x + s4.x, v[j].y * r * g4.y + s4.y); o.y = pk_bf16(v[j].z * r * g4.z + s4.z, v[j].w * r * g4.w + s4.w);
            *(u32x2*)(hb + (size_t)t * D + 256 * j + 4 * lane) = o; }
    }
}
__device__ __forceinline__ void conv_item(const Params& P, int item, int lane) {
    const int rb = item >> 3, g = item & 7, c = g * 64 + lane, t0 = rb * 32, s0 = t0 & (SEQ - 1);
    const bf16_t* aglu = (const bf16_t*)(P.ws + WS_AGLU); bf16_t* ycat = (bf16_t*)(P.ws + WS_YCAT);
    float a[62];
    unsigned short raw[62];
#pragma unroll
    for (int i = 0; i < 62; ++i) { const int tr = (s0 - 30 + i) >= 0 ? (t0 - 30 + i) : t0; raw[i] = aglu[(size_t)tr * 512 + c]; }
    __builtin_amdgcn_sched_barrier(0);
#pragma unroll
    for (int i = 0; i < 62; ++i) a[i] = (s0 - 30 + i) >= 0 ? __uint_as_float((unsigned)raw[i] << 16) : 0.f;
    float w[31];
#pragma unroll
    for (int k = 0; k < 31; ++k) w[k] = P.in[I_CONVW][k * 512 + c];
    const float cb = P.in[I_CONVB][c], gl = P.in[I_GCLN][c], bl = P.in[I_BCLN][c];
    float y[32];
#pragma unroll
    for (int i = 0; i < 32; ++i) { float acc = cb;
#pragma unroll
        for (int k = 0; k < 31; ++k) acc += w[k] * a[i + k];
        y[i] = acc; }
#pragma unroll
    for (int hh = 0; hh < 2; ++hh) {
        float s16[16];
#pragma unroll
        for (int i = 0; i < 16; ++i) s16[i] = y[16 * hh + i];
        const float sm = reduce16(s16, lane);
        float d[16];
#pragma unroll
        for (int i = 0; i < 16; ++i) { const float mean = __int_as_float(__builtin_amdgcn_readlane(__float_as_int(sm), 4 * i)) * (1.f / 64.f); d[i] = y[16 * hh + i] - mean; s16[i] = d[i] * d[i]; }
        const float sv = reduce16(s16, lane);
#pragma unroll
        for (int i = 0; i < 16; ++i) { const float var = __int_as_float(__builtin_amdgcn_readlane(__float_as_int(sv), 4 * i)) * (1.f / 64.f);
            const float z = d[i] * rsqrtf(var + EPS) * gl + bl;
            const float o = z * __builtin_amdgcn_rcpf(1.f + __builtin_amdgcn_exp2f(-1.4426950408889634f * z));
            ycat[(size_t)(t0 + 16 * hh + i) * 1024 + c] = (bf16_t)(pk_bf16(o, 0.f) & 0xffffu); }
    }
}
constexpr int MIX_RS = 136;
__device__ __forceinline__ void mix_item(const Params& P, int item, LAS bf16_t* vnT  , int lane) {
    const int chunk = item >> 3, h = item & 7, tb = chunk * 128, cb = h * 64;
    const bf16_t* ug = (const bf16_t*)(P.ws + WS_UG); const bf16_t* vg = (const bf16_t*)(P.ws + WS_VG); const bf16_t* wsb = (const bf16_t*)(P.ws + WS_WSB) + (size_t)h * 128 * 128;
    bf16_t* ycat = (bf16_t*)(P.ws + WS_YCAT);
    const int fr = lane & 15, fq = lane >> 4;
    bf16x8 wf[8][4]; float bsv[8];
#pragma unroll
    for (int mt = 0; mt < 8; ++mt) { bsv[mt] = P.in[I_BSP][h * 128 + 16 * mt + fr];
#pragma unroll
        for (int ks = 0; ks < 4; ++ks) if (ks <= (mt >> 1)) wf[mt][ks] = *(const bf16x8*)(wsb + (size_t)(16 * mt + fr) * 128 + 32 * ks + 8 * fq); }
    { const int rr = lane >> 3, pc = lane & 7;
      float gl[8], bl[8];
#pragma unroll
      for (int j = 0; j < 8; ++j) { gl[j] = P.in[I_GVLN][cb + pc * 8 + j]; bl[j] = P.in[I_BVLN][cb + pc * 8 + j]; }
      u32x4 wv[16];
#pragma unroll
      for (int it = 0; it < 16; ++it) wv[it] = *(const u32x4*)(vg + (size_t)(tb + it * 8 + rr) * 512 + cb + pc * 8);
      __builtin_amdgcn_sched_barrier(0);
#pragma unroll
      for (int it = 0; it < 16; ++it) { const int t = it * 8 + rr;
          const u32x4 w = wv[it];
          float v[8] = {bf_lo(w.x), bf_hi(w.x), bf_lo(w.y), bf_hi(w.y), bf_lo(w.z), bf_hi(w.z), bf_lo(w.w), bf_hi(w.w)};
          float s = 0.f, ss = 0.f;
#pragma unroll
          for (int j = 0; j < 8; ++j) { s += v[j]; ss += v[j] * v[j]; }
          s += __shfl_xor(s, 1); ss += __shfl_xor(ss, 1); s += __shfl_xor(s, 2); ss += __shfl_xor(ss, 2); s += __shfl_xor(s, 4); ss += __shfl_xor(ss, 4);
          const float mean = s * (1.f / 64.f), var = fmaxf(ss * (1.f / 64.f) - mean * mean, 0.f), rstd = rsqrtf(var + EPS);
#pragma unroll
          for (int j = 0; j < 8; ++j) { const float o = (v[j] - mean) * rstd * gl[j] + bl[j]; vnT[(pc * 8 + j) * MIX_RS + t] = (bf16_t)(pk_bf16(o, 0.f) & 0xffffu); } }
    }
    u32x2 uwa[8][4];
#pragma unroll
    for (int mt = 0; mt < 8; ++mt)
#pragma unroll
        for (int nf = 0; nf < 4; ++nf) uwa[mt][nf] = *(const u32x2*)(ug + (size_t)(tb + 16 * mt + fr) * 512 + cb + 16 * fq + 4 * nf);
    asm volatile("s_waitcnt lgkmcnt(0)" ::: "memory");
#pragma unroll
    for (int mt = 0; mt < 8; ++mt) {
        f32x4 acc[4];
#pragma unroll
        for (int nf = 0; nf < 4; ++nf) acc[nf] = (f32x4){0.f, 0.f, 0.f, 0.f};
        const int t = 16 * mt + fr; const size_t ro = (size_t)(tb + t);
        const u32x2 (&uw)[4] = uwa[mt];
#pragma unroll
        for (int ks = 0; ks < 4; ++ks) if (ks <= (mt >> 1)) {
#pragma unroll
            for (int nf = 0; nf < 4; ++nf) { const bf16x8 vf = *(const LAS bf16x8*)(vnT + (16 * (fr >> 2) + 4 * nf + (fr & 3)) * MIX_RS + 32 * ks + 8 * fq);
                acc[nf] = __builtin_amdgcn_mfma_f32_16x16x32_bf16(vf, wf[mt][ks], acc[nf], 0, 0, 0); }
        }
        const float bs = bsv[mt];
#pragma unroll
        for (int nf = 0; nf < 4; ++nf) {
            u32x2 o; o.x = pk_bf16(bf_lo(uw[nf].x) * (acc[nf][0] + bs), bf_hi(uw[nf].x) * (acc[nf][1] + bs)); o.y = pk_bf16(bf_lo(uw[nf].y) * (acc[nf][2] + bs), bf_hi(uw[nf].y) * (acc[nf][3] + bs));
            *(u32x2*)(ycat + ro * 1024 + 512 + cb + 16 * fq + 4 * nf) = o; }
    }
}
__device__ __forceinline__ void phase1b(const Params& P, LAS unsigned char* lds, int bid, int nblk) {
    const int tid = phase_tid(), lane = tid & 63, wave = tid >> 6;
    LAS bf16_t* vnT = (LAS bf16_t*)lds + wave * 64 * MIX_RS;
    const int gw = bid * 8 + wave, ngw = nblk * 8;
    if (ngw == 2048) {
        if (gw < 1024) { mix_item(P, gw, vnT, lane); conv_item(P, gw, lane); }
        else { conv_item(P, gw, lane); conv_item(P, gw + 1024, lane); conv_item(P, gw + 2048, lane); }
    } else {
        for (int it = gw; it < 1024; it += ngw) mix_item(P, it, vnT, lane);
        for (int it = gw; it < 4096; it += ngw) conv_item(P, it, lane);
    }
}
constexpr int LDS_DYN = 147456;
template <int WHICH> __device__ __forceinline__ void phase_gemm(const Params& P, LAS unsigned char* lds, int bid, int nblk) {
    unsigned char* ws = P.ws;
    if constexpr (WHICH == 1) {
        pg8::Gemm g{(const bf16_t*)(ws + WS_HB), (const bf16_t*)(ws + WS_BT1), T, 2048, 1024}; pg8::StaticOrder S; S.init(T, 2048, nblk, bid);
        pg8::EpiInProj E{(const float*)(ws + WS_BIAS1), (bf16_t*)(ws + WS_AGLU), (bf16_t*)(ws + WS_UG), (bf16_t*)(ws + WS_VG)};
        pg8::gemm_phase<pg8::EpiInProj, pg8::StaticOrder, true, true>(lds, g, S, E);
    } else if constexpr (WHICH == 2) {
        pg8::Gemm g{(const bf16_t*)(ws + WS_YCAT), (const bf16_t*)(ws + WS_BT2), T, 1024, 1024}; pg8::StaticOrder S; S.init(T, 1024, nblk, bid);
        pg8::EpiOutProj E{P.in[I_X], P.in[I_BOUT], (const float*)(ws + WS_COND), P.in[I_G2], (bf16_t*)(ws + WS_X1B), (bf16_t*)(ws + WS_HB), (float*)(ws + WS_PART)};
        pg8::gemm_phase<pg8::EpiOutProj, pg8::StaticOrder, true, true>(lds, g, S, E);
    } else {
        pg8::Gemm g{(const bf16_t*)(ws + WS_HB), (const bf16_t*)(ws + WS_BT3), T, 2048, 1024}; pg8::StaticOrder S; S.init(T, 2048, nblk, bid);
        pg8::EpiQuery E{(const float*)(ws + WS_PART), (const float*)(ws + WS_QB), (bf16_t*)(ws + WS_Q)};
        pg8::gemm_phase<pg8::EpiQuery, pg8::StaticOrder, true, true>(lds, g, S, E);
    }
}
__device__ __forceinline__ int mono(int u) { return u ^ ((u >> 31) & 0x7fffffff); }
template <int N> __device__ __forceinline__ void bitonic_sort_desc(int (&a)[N]) {
#pragma unroll
    for (int k = 2; k <= N; k <<= 1)
#pragma unroll
        for (int j = k >> 1; j > 0; j >>= 1)
#pragma unroll
            for (int i = 0; i < N; ++i) { const int l = i ^ j;
                if (l > i) { const int hi = max(a[i], a[l]), lo = min(a[i], a[l]); if ((i & k) == 0) { a[i] = hi; a[l] = lo; } else { a[i] = lo; a[l] = hi; } } }
}
__device__ __forceinline__ void sort16_desc(int (&a)[16]) {
#define CE(i, j) { const int hi_ = max(a[i], a[j]), lo_ = min(a[i], a[j]); a[i] = hi_; a[j] = lo_; }
    CE(0,13) CE(1,12) CE(2,15) CE(3,14) CE(4,8) CE(5,6) CE(7,11) CE(9,10)
    CE(0,5) CE(1,7) CE(2,9) CE(3,4) CE(6,13) CE(8,14) CE(10,15) CE(11,12)
    CE(0,1) CE(2,3) CE(4,5) CE(6,8) CE(7,9) CE(10,11) CE(12,13) CE(14,15)
    CE(0,2) CE(1,3) CE(4,10) CE(5,11) CE(6,7) CE(8,9) CE(12,14) CE(13,15)
    CE(1,2) CE(3,12) CE(4,6) CE(5,7) CE(8,10) CE(9,11) CE(13,14)
    CE(1,4) CE(2,6) CE(5,8) CE(7,10) CE(9,13) CE(11,14)
    CE(2,4) CE(3,6) CE(9,12) CE(11,13)
    CE(3,5) CE(6,8) CE(7,9) CE(10,12)
    CE(3,4) CE(5,6) CE(7,8) CE(9,10) CE(11,12)
    CE(6,7) CE(8,9)
#undef CE
}
__device__ __forceinline__ void merge_top16(int (&a)[16], const int (&b)[16]) {
#pragma unroll
    for (int j = 0; j < 16; ++j) a[j] = max(a[j], b[15 - j]);
#pragma unroll
    for (int j = 8; j > 0; j >>= 1)
#pragma unroll
        for (int i = 0; i < 16; ++i) { const int l = i ^ j; if (l > i) { const int hi = max(a[i], a[l]), lo = min(a[i], a[l]); a[i] = hi; a[l] = lo; } }
}
__device__ __forceinline__ void merge_quad(int (&a)[16]) {
    int b[16];
#pragma unroll
    for (int j = 0; j < 16; ++j) b[j] = __builtin_amdgcn_ds_swizzle(a[j], 0x401F);
    merge_top16(a, b);
#pragma unroll
    for (int j = 0; j < 16; ++j) b[j] = __shfl_xor(a[j], 32);
    merge_top16(a, b);
}
__device__ __forceinline__ int sel4(int fq, int x0, int x1, int x2, int x3) { const int lo = (fq & 1) ? x1 : x0, hi = (fq & 1) ? x3 : x2; return (fq & 2) ? hi : lo; }
__device__ constexpr int cand_ab(int fq, int s) {
    if (fq == 0) return (0 << 4) | s;
    if (fq == 1) return s < 8 ? ((1 << 4) | s) : (s < 13 ? ((2 << 4) | (s - 8)) : -1);
    if (fq == 2) return s < 4 ? ((3 << 4) | s) : (s < 7 ? ((4 << 4) | (s - 4)) : (s < 9 ? ((5 << 4) | (s - 7)) : (s < 11 ? ((6 << 4) | (s - 9)) : (s < 13 ? ((7 << 4) | (s - 11)) : -1))));
    return s < 8 ? (((8 + s) << 4) | 0) : -1;
}
constexpr int TK_RS = 136;
__device__ __forceinline__ void phase3c(const Params& P, LAS unsigned char* lds, int bid, int nblk) {
    const int tid = phase_tid(), lane = tid & 63, wave = tid >> 6, fr = lane & 15, fq = lane >> 4;
    LAS bf16_t* kl = (LAS bf16_t*)lds;
    LAS unsigned char* isc = lds + 2 * 128 * TK_RS * 2 + wave * 512;
    const bf16_t* q = (const bf16_t*)(P.ws + WS_Q); const bf16_t* keysb = (const bf16_t*)(P.ws + WS_KEYS);
    int* eidx = (int*)(P.ws + WS_EIDX); float* gate = (float*)(P.ws + WS_GATE);
    int cur_h = -1;
    bf16x8 qf[2][4];
#define TK_LOADQ(dst, it_) do { const int h_ = (it_) & 7, t0_ = ((it_) >> 3) * 128 + wave * 16; \
        _Pragma("unroll") for (int i_ = 0; i_ < 2; ++i_) _Pragma("unroll") for (int ks_ = 0; ks_ < 4; ++ks_) dst[i_][ks_] = *(const bf16x8*)(q + (size_t)(t0_ + fr) * 2048 + h_ * 256 + i_ * 128 + 32 * ks_ + 8 * fq); } while (0)
    if (bid < 1024) TK_LOADQ(qf, bid);
    for (int item = bid; item < 1024; item += nblk) {
        const int h = item & 7, tile = item >> 3;
        bf16x8 qn[2][4]; const int nitem = item + nblk < 1024 ? item + nblk : item;
        TK_LOADQ(qn, nitem);
        const bool cv = (nblk == 256); const int cv_r = 2 * ((bid * 8 + wave) * 4 + (item >> 8)) + (lane >> 5), cv_l = lane & 31;
        float4 cu[8], cw[8];
        if (cv) {
#pragma unroll
            for (int j = 0; j < 8; ++j) cu[j] = *(const float4*)(P.in[I_EU] + (size_t)cv_r * D + 32 * cv_l + 4 * j);
#pragma unroll
            for (int j = 0; j < 8; ++j) cw[j] = *(const float4*)(P.in[I_EV] + (size_t)cv_r * D + 128 * j + 4 * cv_l);
        }
        __builtin_amdgcn_sched_barrier(0);
        if (h != cur_h) {
            __syncthreads();
            for (int c = tid; c < 4096; c += 512) { const int row = c >> 4, pc = c & 15;
                const u32x4 v = *(const u32x4*)(keysb + ((size_t)h * 256 + row) * 128 + pc * 8);
                *(LAS u32x4*)(kl + row * TK_RS + pc * 8) = v; }
            __syncthreads();
            cur_h = h;
        }
        const int t0 = tile * 128 + wave * 16;
        int L[2][16];
#pragma unroll
        for (int i = 0; i < 2; ++i) {
            f32x4 S[8];
#pragma unroll
            for (int nf = 0; nf < 8; ++nf) { S[nf] = (f32x4){0.f, 0.f, 0.f, 0.f};
#pragma unroll
                for (int ks = 0; ks < 4; ++ks) { const bf16x8 kf = *(const LAS bf16x8*)(kl + (i * 128 + 16 * nf + fr) * TK_RS + 32 * ks + 8 * fq);
                    S[nf] = __builtin_amdgcn_mfma_f32_16x16x32_bf16(kf, qf[i][ks], S[nf], 0, 0, 0); } }
            int a0[16], a1[16];
#pragma unroll
            for (int nf = 0; nf < 4; ++nf)
#pragma unroll
                for (int r = 0; r < 4; ++r) { a0[4 * nf + r] = (mono(__float_as_int(S[nf][r])) & ~127) | (16 * nf + 4 * fq + r);
                                              a1[4 * nf + r] = (mono(__float_as_int(S[nf + 4][r])) & ~127) | (16 * (nf + 4) + 4 * fq + r); }
            sort16_desc(a0); sort16_desc(a1);
            merge_top16(a0, a1);
            merge_quad(a0);
#pragma unroll
            for (int j = 0; j < 16; ++j) L[i][j] = a0[j];
        }
        if (fq < 2) {
            u32x4 w; unsigned* wp = (unsigned*)&w;
#pragma unroll
            for (int d = 0; d < 4; ++d) { const int x0 = fq ? L[1][4 * d] : L[0][4 * d], x1 = fq ? L[1][4 * d + 1] : L[0][4 * d + 1], x2 = fq ? L[1][4 * d + 2] : L[0][4 * d + 2], x3 = fq ? L[1][4 * d + 3] : L[0][4 * d + 3];
                wp[d] = (unsigned)(x0 & 127) | ((unsigned)(x1 & 127) << 8) | ((unsigned)(x2 & 127) << 16) | ((unsigned)(x3 & 127) << 24); }
            *(LAS u32x4*)(isc + fr * 32 + fq * 16) = w;
        }
        int cnd[16];
#pragma unroll
        for (int s = 0; s < 16; ++s) {
            constexpr int NEG = (int)0x80000000;
            const int c0 = cand_ab(0, s), c1 = cand_ab(1, s), c2 = cand_ab(2, s), c3 = cand_ab(3, s);
            const int ka = sel4(fq, L[0][c0 >> 4], c1 >= 0 ? L[0][(c1 >> 4) & 15] : 0, c2 >= 0 ? L[0][(c2 >> 4) & 15] : 0, c3 >= 0 ? L[0][(c3 >> 4) & 15] : 0);
            const int kb = sel4(fq, L[1][c0 & 15], c1 >= 0 ? L[1][c1 & 15] : 0, c2 >= 0 ? L[1][c2 & 15] : 0, c3 >= 0 ? L[1][c3 & 15] : 0);
            const int code = sel4(fq, c0, c1, c2, c3);
            const float sum = __int_as_float(mono(ka & ~127)) + __int_as_float(mono(kb & ~127));
            const int key = (mono(__float_as_int(sum)) & ~255) | (code & 255);
            cnd[s] = code < 0 ? NEG : key;
        }
        sort16_desc(cnd);
        merge_quad(cnd);
        const float vmax = __int_as_float(mono(cnd[0] & ~255));
        int kk[4]; float ee[4]; float esum = 0.f;
#pragma unroll
        for (int j = 0; j < 4; ++j) { kk[j] = sel4(fq, cnd[j], cnd[4 + j], cnd[8 + j], cnd[12 + j]);
            ee[j] = __builtin_amdgcn_exp2f((__int_as_float(mono(kk[j] & ~255)) - vmax) * 1.4426950408889634f); esum += ee[j]; }
        esum += __int_as_float(__builtin_amdgcn_ds_swizzle(__float_as_int(esum), 0x401F)); esum += __shfl_xor(esum, 32);
        const float rs = __builtin_amdgcn_rcpf(esum);
        asm volatile("s_waitcnt lgkmcnt(0)" ::: "memory");
        int4 eo; float4 go; int* ep = (int*)&eo; float* gp = (float*)&go;
#pragma unroll
        for (int j = 0; j < 4; ++j) { const int code = kk[j] & 255; const int ia = isc[fr * 32 + (code >> 4)], ib = isc[fr * 32 + 16 + (code & 15)]; ep[j] = ia * 128 + ib; gp[j] = ee[j] * rs; }
        *(int4*)(eidx + (size_t)(t0 + fr) * 128 + h * 16 + 4 * fq) = eo;
        *(float4*)(gate + (size_t)(t0 + fr) * 128 + h * 16 + 4 * fq) = go;
        if (cv) { convert_row_umx_from(cu, P.ws + WS_UFP8 + (size_t)cv_r * 512, P.ws + WS_USC + (size_t)cv_r * 32, cv_l);
                  convert_row_from<FMT_V>(cw, P.ws + WS_VFP8 + (size_t)cv_r * RowFmt<FMT_V>::RSB, (float*)(P.ws + WS_VSC + (size_t)cv_r * 64), cv_l); }
#pragma unroll
        for (int i_ = 0; i_ < 2; ++i_)
#pragma unroll
            for (int ks_ = 0; ks_ < 4; ++ks_) qf[i_][ks_] = qn[i_][ks_];
    }
#undef TK_LOADQ
    __syncthreads();
}
#define XB_TMO      128
#define XB_XCNT(j)  (256  + 64 * (j))
#define XB_XSUB(j)  (1280 + 64 * (j))
#define XB_XGEN(j)  (2304 + 64 * (j))
#define XB_TOP      3328
#define XB_TOPGEN   3392
#define XCD_BAR_WORDS 3456
#define XB_SPIN_CAP (1u << 18)

__device__ __forceinline__ unsigned xb_ld(unsigned* p)              { return __hip_atomic_load(p, __ATOMIC_RELAXED, __HIP_MEMORY_SCOPE_AGENT); }
__device__ __forceinline__ unsigned xb_add(unsigned* p, unsigned v) { return __hip_atomic_fetch_add(p, v, __ATOMIC_RELAXED, __HIP_MEMORY_SCOPE_AGENT); }
__device__ __forceinline__ unsigned xb_xcc_id() { return (unsigned)__builtin_amdgcn_s_getreg((3 << 11) | 20) & 0xFu; }
#define XB_SPIN(cond, bar) do { unsigned _sp = 0; while (cond) { __builtin_amdgcn_s_sleep(1); \
    if ((++_sp & 255u) == 0u) { if (xb_ld(&(bar)[XB_TMO])) break; if (_sp > XB_SPIN_CAP) { atomicAdd(&(bar)[XB_TMO], 1u); break; } } } } while (0)

struct XcdBarrier {
    unsigned* bar; unsigned x;
    volatile LAS unsigned* st;
};

__device__ __forceinline__ XcdBarrier xcd_barrier_post(unsigned* bar, volatile LAS unsigned* st) {
    XcdBarrier b; b.bar = bar; b.x = xb_xcc_id(); b.st = st;
    if (threadIdx.x == 0) (void)xb_add(&bar[XB_XCNT(b.x)], 1u);
    return b;
}
__device__ __forceinline__ void xcd_barrier_complete(unsigned* bar, unsigned x, unsigned& nloc, unsigned& nx) {
    const unsigned G = gridDim.x * gridDim.y * gridDim.z;
    unsigned sum, cnt, mine, sp = 0u;
    for (;;) {
        sum = 0u; cnt = 0u; mine = 0u;
#pragma unroll
        for (unsigned j = 0; j < 16; ++j) { const unsigned c = xb_ld(&bar[XB_XCNT(j)]); sum += c; cnt += (c > 0u) ? 1u : 0u; mine = (j == x) ? c : mine; }
        if (sum == G) break;
        __builtin_amdgcn_s_sleep(1);
        if ((++sp & 255u) == 0u) { if (xb_ld(&bar[XB_TMO])) break; if (sp > XB_SPIN_CAP) { atomicAdd(&bar[XB_TMO], 1u); break; } }
    }
    nloc = mine > 0u ? mine : 1u; nx = cnt > 0u ? cnt : 1u;
}

__device__ __forceinline__ void xcd_barrier(const XcdBarrier& b) {
    asm volatile("s_waitcnt vmcnt(0)" ::: "memory");
    __syncthreads();
    if (threadIdx.x == 0) {
        unsigned* bar = b.bar;
        __builtin_amdgcn_s_waitcnt(0);
        unsigned nloc = b.st[0], nx = b.st[1];
        if (nloc == 0u) { xcd_barrier_complete(bar, b.x, nloc, nx); b.st[0] = nloc; b.st[1] = nx; }
        const unsigned old = xb_add(&bar[XB_XSUB(b.x)], 1u);
        const unsigned gen = old / nloc;
        if (old + 1u == (gen + 1u) * nloc) {
            __builtin_amdgcn_fence(__ATOMIC_RELEASE, "agent");
            asm volatile("s_waitcnt vmcnt(0)" ::: "memory");
            const unsigned og = xb_add(&bar[XB_TOP], 1u);
            const unsigned tg = og / nx;
            if (og + 1u == (tg + 1u) * nx) xb_add(&bar[XB_TOPGEN], 1u);
            else XB_SPIN(xb_ld(&bar[XB_TOPGEN]) == tg, bar);
            __builtin_amdgcn_fence(__ATOMIC_ACQUIRE, "agent");
            xb_add(&bar[XB_XGEN(b.x)], 1u);
            asm volatile("s_waitcnt vmcnt(0)" ::: "memory");
        } else {
            XB_SPIN(xb_ld(&bar[XB_XGEN(b.x)]) == gen, bar);
            __builtin_amdgcn_fence(__ATOMIC_ACQUIRE, "agent");
            asm volatile("s_waitcnt vmcnt(0)" ::: "memory");
        }
    }
    __syncthreads();
}

constexpr int LDS_BARST = LDS_DYN - 64;
constexpr int CW_BAR = 1024;
constexpr size_t CTL_ZERO_BYTES = 32768;
__global__ void __launch_bounds__(512, 2) k_mega(Params P) {
    extern __shared__ __attribute__((aligned(16))) unsigned char lds[];
    LAS unsigned char* l3 = (LAS unsigned char*)lds;
    const int bid = blockIdx.x, nblk = gridDim.x;
    volatile LAS unsigned* st = (volatile LAS unsigned*)(l3 + LDS_BARST);
    if (threadIdx.x < 2) st[threadIdx.x] = 0u;
    __syncthreads();
    XcdBarrier bar = xcd_barrier_post((unsigned*)(P.ws + WS_CTL) + CW_BAR, st);
#define GRID_BAR() do { xcd_barrier(bar); } while (0)
#ifndef REP_MASK
#define REP_MASK 0
#endif
#define RUN(k, call) do { call; GRID_BAR(); if (REP_MASK & (1 << (k))) { call; GRID_BAR(); } } while (0)
    RUN(0, phase0(P, (float*)lds, bid, nblk));
    RUN(1, phase0b(P, (float*)lds, bid, nblk));
    RUN(2, phase_gemm<1>(P, l3, bid, nblk));
    RUN(3, phase1b(P, l3, bid, nblk));
    RUN(4, phase_gemm<2>(P, l3, bid, nblk));
    RUN(5, phase_gemm<3>(P, l3, bid, nblk));
    RUN(6, phase3c(P, l3, bid, nblk));
#undef RUN
#ifdef PEER_PROBE
    phase_peer<PEER_PROBE>(P, (float*)lds, bid, nblk, (float*)(P.ws + WS_Q));
    GRID_BAR();
#endif
    phase_peer<0>(P, (float*)lds, bid, nblk, P.out);
#undef GRID_BAR
}

extern "C" void kernel_launch(void* const* d_in, const int* in_sizes, int n_in, void* d_out, int out_size, void* d_ws, size_t ws_size, hipStream_t stream) {
    if (n_in != 23 || ws_size < 256 * MiB) { fprintf(stderr, "kernel_launch: unexpected n_in %d or ws_size %zu\n", n_in, ws_size); return; }
    static int grid = 0;
    if (grid == 0) {
        int dev = 0, cus = 0;
        if (hipGetDevice(&dev) != hipSuccess || hipDeviceGetAttribute(&cus, hipDeviceAttributeMultiprocessorCount, dev) != hipSuccess || cus <= 0) { fprintf(stderr, "kernel_launch: device query failed\n"); grid = -1; return; }
        if (hipFuncSetAttribute((const void*)k_mega, hipFuncAttributeMaxDynamicSharedMemorySize, LDS_DYN) != hipSuccess) { fprintf(stderr, "kernel_launch: hipFuncSetAttribute failed\n"); grid = -1; return; }
        int per_cu = 0;
        if (hipOccupancyMaxActiveBlocksPerMultiprocessor(&per_cu, (const void*)k_mega, 512, LDS_DYN) != hipSuccess || per_cu < 1) { fprintf(stderr, "kernel_launch: occupancy query says %d blocks/CU\n", per_cu); }
        (void)hipGetLastError();
        grid = cus;
    }
    if (grid < 0) return;
    Params P{};
    for (int i = 0; i < 23; ++i) P.in[i] = (const float*)d_in[i];
    P.out = (float*)d_out; P.ws = (unsigned char*)d_ws;
    hipMemsetAsync((char*)d_ws + WS_CTL, 0, CTL_ZERO_BYTES, stream);
    hipLaunchKernelGGL(k_mega, dim3(grid), dim3(512), LDS_DYN, stream, P);
}
```

```cpp
#include <hip/hip_runtime.h>
#include <cstdio>
#include <cstdint>

constexpr int D = 1024, BATCH = 2, SEQ = 8192, T = BATCH * SEQ;
constexpr int DCONV = 512, DG = 512, NPROJ = 2048, CW = 31, CHUNK = 128;
constexpr int NKEYS = 128, NEXP = 16384, PH = 8, DKEY = 256, DHALF = 128, TOPK = 16;
constexpr float EPS = 1e-6f;

__device__ __forceinline__ float gelu_tanh(float x) { return 0.5f * x * (1.f + tanhf(0.7978845608028654f * (x + 0.044715f * x * x * x))); }
__device__ __forceinline__ float sigmoidf_(float x) { return 1.f / (1.f + expf(-x)); }
__device__ __forceinline__ int phase_tid() { int t = threadIdx.x; asm volatile("" : "+v"(t)); return t; }
__device__ __forceinline__ float wave_sum(float v) {
#pragma unroll
    for (int o = 1; o < 64; o <<= 1) v += __shfl_xor(v, o);
    return v;
}

typedef float f32x2 __attribute__((ext_vector_type(2)));
__device__ __forceinline__ float gelu_fast(float x) {
    const float z = x * (0.7978845608028654f + 0.035677408136300125f * x * x);
    return x * __builtin_amdgcn_rcpf(1.f + __builtin_amdgcn_exp2f(-2.885390081777927f * z));
}
#define SWZ(v, pat) __int_as_float(__builtin_amdgcn_ds_swizzle(__float_as_int(v), pat))
__device__ __forceinline__ float reduce16(const float (&s)[16], int lane) {
    float t[8];
#pragma unroll
    for (int k = 0; k < 8; ++k) { auto r = __builtin_amdgcn_permlane32_swap(__float_as_uint(s[k]), __float_as_uint(s[k + 8]), false, false); t[k] = __uint_as_float(r[0]) + __uint_as_float(r[1]); }
    const bool b4 = lane & 16, b3 = lane & 8, b2 = lane & 4;
    float u[4];
#pragma unroll
    for (int k = 0; k < 4; ++k) { const float keep = b4 ? t[k + 4] : t[k], send = b4 ? t[k] : t[k + 4]; u[k] = keep + SWZ(send, 0x401F); }
    float v[2];
#pragma unroll
    for (int k = 0; k < 2; ++k) { const float keep = b3 ? u[k + 2] : u[k], send = b3 ? u[k] : u[k + 2]; v[k] = keep + SWZ(send, 0x201F); }
    const float keep = b2 ? v[1] : v[0], send = b2 ? v[0] : v[1];
    float w = keep + SWZ(send, 0x101F);
    w += SWZ(w, 0x081F); w += SWZ(w, 0x041F);
    return w;
}
namespace pg8 {
#define PG8_LAS __attribute__((address_space(3)))
typedef unsigned short bf16_t;
typedef short bf16x8 __attribute__((ext_vector_type(8)));
typedef float f32x4 __attribute__((ext_vector_type(4)));
typedef unsigned u32x4 __attribute__((ext_vector_type(4)));
constexpr int BM = 256, BK = 64, HALF = 128, HTB = HALF * BK * 2  , STAGE_BYTES = 8 * HTB, NXCD = 8, WGM = 8;

__host__ __device__ __forceinline__ int lds_byte(int r, int c) { const int st = (r >> 4) * 2 + (c >> 5), rr = r & 15, cc = c & 31, ob = rr * 64 + cc * 2; return st * 1024 + (ob ^ (((ob >> 9) & 1) << 5)); }
__host__ __device__ __forceinline__ void stage_rc(int b, int& R, int& C) { const int st = b / 1024, sb = b % 1024, swz = sb ^ (((sb >> 9) & 1) << 5); R = (st >> 1) * 16 + swz / 64; C = (st & 1) * 32 + (swz % 64) / 2; }
__host__ __device__ __forceinline__ int perm32(int rho) { const int n = rho >> 4, i = rho & 15; return 8 * (i >> 2) + 4 * n + (i & 3); }

struct Unit { int pm, pn; };
struct Gemm { const bf16_t* A; const bf16_t* Bt; int M, N, K; };

struct StaticOrder {
    int nM, nN, nwg, G, c;
    __host__ __device__ void init(int M, int N, int G_, int c_) { nM = M / BM; nN = N / BM; nwg = nM * nN; G = G_; c = c_; }
    __host__ __device__ bool next(int i, Unit& u) const {
        const long L = (long)i * G + c; if (L >= nwg) return false;
        int wgid = (int)L; { const int q = nwg / NXCD, r = nwg % NXCD, xcd = wgid % NXCD, off = wgid / NXCD; wgid = (xcd < r ? xcd * (q + 1) : r * (q + 1) + (xcd - r) * q) + off; }
        const int nig = WGM * nN, gid = wgid / nig, fm = gid * WGM, gsz = (nM - fm) < WGM ? (nM - fm) : WGM;
        u.pm = fm + ((wgid % nig) % gsz); u.pn = (wgid % nig) / gsz; return true;
    }
    __device__ __forceinline__ void a_ready(const Unit&) const {}
    __device__ __forceinline__ void done(const Unit&) const {}
};


__device__ __forceinline__ unsigned cvt_pk_bf16(float lo, float hi) { unsigned r; asm volatile("v_cvt_pk_bf16_f32 %0, %1, %2" : "=v"(r) : "v"(lo), "v"(hi)); return r; }
__device__ __forceinline__ float sigm_fast(float x) { return __builtin_amdgcn_rcpf(1.f + __builtin_amdgcn_exp2f(-1.4426950408889634f * x)); }
__device__ __forceinline__ float gelu_f(float x) { const float z = x * (0.7978845608028654f + 0.035677408136300125f * x * x); return x * __builtin_amdgcn_rcpf(1.f + __builtin_amdgcn_exp2f(-2.885390081777927f * z)); }
typedef unsigned u32x2 __attribute__((ext_vector_type(2)));

struct EpiInProj {
    static constexpr bool PERM = true, AFTER_DRAIN = false;
    const float* bias; bf16_t* aglu; bf16_t* ug; bf16_t* vg;
    __device__ __forceinline__ void operator()(const f32x4 (&acc)[2][2][4][2], const Unit& u, int wr, int wc, int fr, int fq) const {
        const int row0 = u.pm * BM + wr * 64 + fr, cc = wc * 32 + 8 * fq;
        f32x4 bv[2][2];
#pragma unroll
        for (int bj = 0; bj < 2; ++bj)
#pragma unroll
            for (int n = 0; n < 2; ++n) bv[bj][n] = *(const f32x4*)(bias + u.pn * BM + bj * HALF + cc + 4 * n);
        if (u.pn < 4) {
            bf16_t* base = aglu + u.pn * HALF + cc;
#pragma unroll
            for (int ai = 0; ai < 2; ++ai)
#pragma unroll
                for (int m = 0; m < 4; ++m) { const size_t row = (size_t)(row0 + ai * HALF + m * 16);
                    float a[8];
#pragma unroll
                    for (int n = 0; n < 2; ++n) { const f32x4 v = acc[ai][0][m][n] + bv[0][n], g = acc[ai][1][m][n] + bv[1][n];
#pragma unroll
                        for (int j = 0; j < 4; ++j) a[4 * n + j] = v[j] * sigm_fast(g[j]); }
                    u32x4 w; w.x = cvt_pk_bf16(a[0], a[1]); w.y = cvt_pk_bf16(a[2], a[3]); w.z = cvt_pk_bf16(a[4], a[5]); w.w = cvt_pk_bf16(a[6], a[7]);
                    *(u32x4*)(base + row * 512) = w; }
        } else {
            const int off = (u.pn - 4) * HALF + cc;
#pragma unroll
            for (int ai = 0; ai < 2; ++ai)
#pragma unroll
                for (int m = 0; m < 4; ++m) { const size_t row = (size_t)(row0 + ai * HALF + m * 16);
#pragma unroll
                    for (int bj = 0; bj < 2; ++bj) { float a[8];
#pragma unroll
                        for (int n = 0; n < 2; ++n) { const f32x4 v = acc[ai][bj][m][n] + bv[bj][n];
#pragma unroll
                            for (int j = 0; j < 4; ++j) a[4 * n + j] = gelu_f(v[j]); }
                        u32x4 w; w.x = cvt_pk_bf16(a[0], a[1]); w.y = cvt_pk_bf16(a[2], a[3]); w.z = cvt_pk_bf16(a[4], a[5]); w.w = cvt_pk_bf16(a[6], a[7]);
                        *(u32x4*)((bj == 0 ? ug : vg) + row * 512 + off) = w; } }
        }
    }
};

struct EpiOutProj {
    static constexpr bool PERM = true, AFTER_DRAIN = false;
    const float* x; const float* b_out; const float* cond; const float* g2; bf16_t* x1; bf16_t* xg; float* part;
    __device__ __forceinline__ void operator()(const f32x4 (&acc)[2][2][4][2], const Unit& u, int wr, int wc, int fr, int fq) const {
        const int row0 = u.pm * BM + wr * 64 + fr, col0 = u.pn * BM + wc * 32 + 8 * fq, b = (u.pm * BM) >> 13;
        const float* cb = cond + b * 6144;
        float ssq[2][4];
#pragma unroll
        for (int ai = 0; ai < 2; ++ai)
#pragma unroll
            for (int m = 0; m < 4; ++m) ssq[ai][m] = 0.f;
#pragma unroll
        for (int bj = 0; bj < 2; ++bj) { const int col = col0 + bj * HALF;
            f32x4 bo[2], gt[2], gg[2];
#pragma unroll
            for (int n = 0; n < 2; ++n) { bo[n] = *(const f32x4*)(b_out + col + 4 * n); gt[n] = *(const f32x4*)(cb + 2048 + col + 4 * n); gg[n] = *(const f32x4*)(g2 + col + 4 * n) * (*(const f32x4*)(cb + 4096 + col + 4 * n) + 1.0f); }
#pragma unroll
            for (int am = 0; am < 4; ++am) { const int ai = am >> 1;
                f32x4 xl[4][2];
#pragma unroll
                for (int m = 2 * (am & 1); m < 2 * (am & 1) + 2; ++m)
#pragma unroll
                    for (int n = 0; n < 2; ++n) xl[m][n] = *(const f32x4*)(x + (size_t)(row0 + ai * HALF + m * 16) * 1024 + col + 4 * n);
                __builtin_amdgcn_sched_barrier(0);
#pragma unroll
                for (int m = 2 * (am & 1); m < 2 * (am & 1) + 2; ++m) { const size_t off = (size_t)(row0 + ai * HALF + m * 16) * 1024 + col;
                    const f32x4 r0 = xl[m][0] + gt[0] * (acc[ai][bj][m][0] + bo[0]), r1 = xl[m][1] + gt[1] * (acc[ai][bj][m][1] + bo[1]);
                    { u32x4 wx; wx.x = cvt_pk_bf16(r0[0], r0[1]); wx.y = cvt_pk_bf16(r0[2], r0[3]); wx.z = cvt_pk_bf16(r1[0], r1[1]); wx.w = cvt_pk_bf16(r1[2], r1[3]); *(u32x4*)(x1 + off) = wx; }
                    ssq[ai][m] += ((r0[0] * r0[0] + r0[1] * r0[1]) + (r0[2] * r0[2] + r0[3] * r0[3])) + ((r1[0] * r1[0] + r1[1] * r1[1]) + (r1[2] * r1[2] + r1[3] * r1[3]));
                    const f32x4 h0 = r0 * gg[0], h1 = r1 * gg[1]; u32x4 w; w.x = cvt_pk_bf16(h0[0], h0[1]); w.y = cvt_pk_bf16(h0[2], h0[3]); w.z = cvt_pk_bf16(h1[0], h1[1]); w.w = cvt_pk_bf16(h1[2], h1[3]);
                    *(u32x4*)(xg + off) = w; } } }
#pragma unroll
        for (int ai = 0; ai < 2; ++ai)
#pragma unroll
            for (int m = 0; m < 4; ++m) { float s = ssq[ai][m]; s += __shfl_xor(s, 16); s += __shfl_xor(s, 32);
                if (fq == 0) part[(size_t)(row0 + ai * HALF + m * 16) * 16 + u.pn * 4 + wc] = s; }
    }
};

struct EpiQuery {
    static constexpr bool PERM = true, AFTER_DRAIN = false;
    const float* part; const float* qb; bf16_t* q;
    __device__ __forceinline__ void operator()(const f32x4 (&acc)[2][2][4][2], const Unit& u, int wr, int wc, int fr, int fq) const {
        const int row0 = u.pm * BM + wr * 64 + fr, col0 = u.pn * BM + wc * 32 + 8 * fq, b = (u.pm * BM) >> 13;
        f32x4 qv[2][2];
#pragma unroll
        for (int bj = 0; bj < 2; ++bj)
#pragma unroll
            for (int n = 0; n < 2; ++n) qv[bj][n] = *(const f32x4*)(qb + b * 2048 + col0 + bj * HALF + 4 * n);
#pragma unroll
        for (int ai = 0; ai < 2; ++ai) {
            f32x4 pl[4];
#pragma unroll
            for (int m = 0; m < 4; ++m) pl[m] = *(const f32x4*)(part + (size_t)(row0 + ai * HALF + m * 16) * 16 + 4 * fq);
            __builtin_amdgcn_sched_barrier(0);
#pragma unroll
            for (int m = 0; m < 4; ++m) { const size_t row = (size_t)(row0 + ai * HALF + m * 16);
                const f32x4 p4 = pl[m];
                float s = (p4[0] + p4[1]) + (p4[2] + p4[3]); s += __shfl_xor(s, 16); s += __shfl_xor(s, 32);
                const float r = rsqrtf(s * (1.f / 1024.f) + 1e-6f);
#pragma unroll
                for (int bj = 0; bj < 2; ++bj) { const f32x4 v0 = acc[ai][bj][m][0] * r + qv[bj][0], v1 = acc[ai][bj][m][1] * r + qv[bj][1];
                    u32x4 w; w.x = cvt_pk_bf16(v0[0], v0[1]); w.y = cvt_pk_bf16(v0[2], v0[3]); w.z = cvt_pk_bf16(v1[0], v1[1]); w.w = cvt_pk_bf16(v1[2], v1[3]);
                    *(u32x4*)(q + row * 2048 + col0 + bj * HALF) = w; } } }
    }
};
template <class Epi, class Sched, bool ALIGN_EPI = false, bool SP2 = false>
__device__ __forceinline__ void gemm_phase(PG8_LAS unsigned char* lds, const Gemm g, const Sched& S, const Epi& E) {
    const int tid = phase_tid(), wid = __builtin_amdgcn_readfirstlane(tid >> 6), lane = tid & 63, wr = wid >> 2, wc = wid & 3, fr = lane & 15, fq = lane >> 4;
    const int K = g.K, nt = K / BK;
    unsigned voffA[2], voffB[2];
#pragma unroll
    for (int i = 0; i < 2; ++i) { int R, C; stage_rc(tid * 16 + i * 8192, R, C); const int Rb = Epi::PERM ? ((R & ~31) + perm32(R & 31)) : R;
        voffA[i] = (unsigned)(R * K + C) * 2u; voffB[i] = (unsigned)(Rb * K + C) * 2u; }
    const size_t kstep = (size_t)(BK * 2);
    const size_t hstep = (size_t)HALF * K * 2;
    const size_t tstep = 2 * hstep;
    const unsigned ldsw = (unsigned)wid * 1024u;
    const int aoff = lds_byte(wr * 64 + fr, fq * 8), boff = lds_byte(wc * 32 + fr, fq * 8);
#define PG8_SA(b, h) (((b) * 2 + (h)) * HTB)
#define PG8_SB(b, h) ((4 + (b) * 2 + (h)) * HTB)
#define PG8_STAGE(bufoff, gbase, voff) do { _Pragma("unroll") for (int _i = 0; _i < 2; ++_i) \
        __builtin_amdgcn_global_load_lds((const unsigned*)((const char*)(gbase) + (voff)[_i]), (PG8_LAS unsigned*)(lds + (bufoff) + ldsw + _i * 8192), 16, 0, 0); } while (0)
#define PG8_LDA(dst, b, h) do { _Pragma("unroll") for (int m = 0; m < 4; ++m) _Pragma("unroll") for (int k = 0; k < 2; ++k) dst[m][k] = *(const PG8_LAS bf16x8*)(lds + PG8_SA(b, h) + aoff + m * 2048 + k * 1024); } while (0)
#define PG8_LDB(dst, b, h) do { _Pragma("unroll") for (int n = 0; n < 2; ++n) _Pragma("unroll") for (int k = 0; k < 2; ++k) dst[n][k] = *(const PG8_LAS bf16x8*)(lds + PG8_SB(b, h) + boff + n * 2048 + k * 1024); } while (0)
#define PG8_MMA(ai, bj, At, Bt) do { __builtin_amdgcn_s_setprio(1); _Pragma("unroll") for (int m = 0; m < 4; ++m) _Pragma("unroll") for (int n = 0; n < 2; ++n) _Pragma("unroll") for (int k = 0; k < 2; ++k) \
        acc[ai][bj][m][n] = __builtin_amdgcn_mfma_f32_16x16x32_bf16(Bt[n][k], At[m][k], acc[ai][bj][m][n], 0, 0, 0); __builtin_amdgcn_s_setprio(0); } while (0)
#define PG8_WAIT_V(n) asm volatile("s_waitcnt vmcnt(" #n ")" ::: "memory")
#define PG8_WAIT_L(n) asm volatile("s_waitcnt lgkmcnt(" #n ")" ::: "memory")
#define PG8_BAR __builtin_amdgcn_s_barrier()
#define PG8_SCHED __builtin_amdgcn_sched_barrier(0)
    Unit cur, nxt; int ui = 0;
    if (!S.next(0, cur)) return;
    f32x4 acc[2][2][4][2];
#pragma unroll
    for (int a = 0; a < 2; ++a)
#pragma unroll
        for (int b = 0; b < 2; ++b)
#pragma unroll
            for (int m = 0; m < 4; ++m)
#pragma unroll
                for (int n = 0; n < 2; ++n) acc[a][b][m][n] = (f32x4){0.f, 0.f, 0.f, 0.f};
    bf16x8 At[4][2], B0[2][2], B1[2][2];
    const char* cA = (const char*)g.A + (size_t)cur.pm * tstep; const char* cB = (const char*)g.Bt + (size_t)cur.pn * tstep;
    S.a_ready(cur);
    if constexpr (SP2) {
        PG8_STAGE(PG8_SB(0, 0), cB, voffB); PG8_STAGE(PG8_SB(0, 1), cB + hstep, voffB); PG8_STAGE(PG8_SA(0, 0), cA, voffA); PG8_STAGE(PG8_SA(0, 1), cA + hstep, voffA);
        if (wr == 1) PG8_BAR;
        PG8_WAIT_V(2); PG8_BAR;
        PG8_STAGE(PG8_SB(1, 0), cB + kstep, voffB); PG8_STAGE(PG8_SA(1, 0), cA + kstep, voffA); PG8_STAGE(PG8_SB(1, 1), cB + hstep + kstep, voffB);
        PG8_WAIT_V(6); PG8_BAR;
    } else {
        PG8_STAGE(PG8_SB(0, 0), cB, voffB); PG8_STAGE(PG8_SA(0, 0), cA, voffA); PG8_STAGE(PG8_SB(0, 1), cB + hstep, voffB); PG8_STAGE(PG8_SA(0, 1), cA + hstep, voffA);
        if (wr == 1) PG8_BAR;
        PG8_WAIT_V(4); PG8_BAR;
        PG8_STAGE(PG8_SB(1, 0), cB + kstep, voffB); PG8_STAGE(PG8_SA(1, 0), cA + kstep, voffA); PG8_STAGE(PG8_SB(1, 1), cB + hstep + kstep, voffB);
        PG8_WAIT_V(6); PG8_BAR;
    }
    for (;;) {
        const bool has_next = S.next(ui + 1, nxt);
        const char* nA = has_next ? (const char*)g.A + (size_t)nxt.pm * tstep : cA; const char* nB = has_next ? (const char*)g.Bt + (size_t)nxt.pn * tstep : cB;
        for (int t = 0; t < nt; t += 2) {
            const bool last = (t == nt - 2);
            const char* a1 = cA + (size_t)(t + 1) * kstep;
            const char* a2 = last ? nA : cA + (size_t)(t + 2) * kstep; const char* b2 = last ? nB : cB + (size_t)(t + 2) * kstep;
            const char* a3 = a2 + kstep; const char* b3 = b2 + kstep;
            if (last && has_next) S.a_ready(nxt);
            if constexpr (SP2) {
            PG8_LDB(B0, 0, 0); PG8_LDB(B1, 0, 1); PG8_SCHED; PG8_LDA(At, 0, 0); PG8_STAGE(PG8_SA(1, 1), a1 + hstep, voffA);
            PG8_WAIT_V(8); PG8_WAIT_L(0); PG8_BAR; PG8_MMA(0, 0, At, B0); PG8_MMA(0, 1, At, B1); PG8_BAR; PG8_SCHED;
            PG8_LDA(At, 0, 1); PG8_STAGE(PG8_SB(0, 0), b2, voffB); PG8_STAGE(PG8_SB(0, 1), b2 + hstep, voffB); PG8_STAGE(PG8_SA(0, 0), a2, voffA);
            PG8_WAIT_V(8); PG8_WAIT_L(0); PG8_BAR; PG8_MMA(1, 0, At, B0); PG8_MMA(1, 1, At, B1); PG8_BAR; PG8_SCHED;
            PG8_LDB(B0, 1, 0); PG8_LDB(B1, 1, 1); PG8_SCHED; PG8_LDA(At, 1, 0); PG8_STAGE(PG8_SA(0, 1), a2 + hstep, voffA);
            PG8_WAIT_V(8); PG8_WAIT_L(0); PG8_BAR; PG8_MMA(0, 0, At, B0); PG8_MMA(0, 1, At, B1); PG8_BAR; PG8_SCHED;
            PG8_LDA(At, 1, 1); PG8_STAGE(PG8_SB(1, 0), b3, voffB); PG8_STAGE(PG8_SB(1, 1), b3 + hstep, voffB); PG8_STAGE(PG8_SA(1, 0), a3, voffA);
            PG8_WAIT_V(8); PG8_WAIT_L(0); PG8_BAR; PG8_MMA(1, 0, At, B0); PG8_MMA(1, 1, At, B1); PG8_BAR; PG8_SCHED;
            } else {
            PG8_LDB(B0, 0, 0); PG8_SCHED; PG8_LDA(At, 0, 0); PG8_STAGE(PG8_SA(1, 1), a1 + hstep, voffA);
            PG8_WAIT_L(8); PG8_BAR; PG8_WAIT_L(0); PG8_MMA(0, 0, At, B0); PG8_BAR; PG8_SCHED;
            PG8_LDB(B1, 0, 1); PG8_STAGE(PG8_SB(0, 0), b2, voffB);
            PG8_BAR; PG8_WAIT_L(0); PG8_MMA(0, 1, At, B1); PG8_BAR;
            PG8_LDA(At, 0, 1); PG8_STAGE(PG8_SA(0, 0), a2, voffA);
            PG8_BAR; PG8_WAIT_L(0); PG8_MMA(1, 0, At, B0); PG8_BAR; PG8_SCHED;
            PG8_STAGE(PG8_SB(0, 1), b2 + hstep, voffB);
            PG8_WAIT_V(6); PG8_BAR; PG8_MMA(1, 1, At, B1); PG8_BAR;
            PG8_LDB(B0, 1, 0); PG8_SCHED; PG8_LDA(At, 1, 0); PG8_STAGE(PG8_SA(0, 1), a2 + hstep, voffA);
            PG8_WAIT_L(8); PG8_BAR; PG8_WAIT_L(0); PG8_MMA(0, 0, At, B0); PG8_BAR; PG8_SCHED;
            PG8_LDB(B1, 1, 1); PG8_STAGE(PG8_SB(1, 0), b3, voffB);
            PG8_BAR; PG8_WAIT_L(0); PG8_MMA(0, 1, At, B1); PG8_BAR;
            PG8_LDA(At, 1, 1); PG8_STAGE(PG8_SA(1, 0), a3, voffA);
            PG8_BAR; PG8_WAIT_L(0); PG8_MMA(1, 0, At, B0); PG8_BAR; PG8_SCHED;
            PG8_STAGE(PG8_SB(1, 1), b3 + hstep, voffB);
            PG8_WAIT_V(6); PG8_BAR; PG8_MMA(1, 1, At, B1); PG8_BAR;
            }
        }
        if constexpr (ALIGN_EPI) { if (wr == 0) PG8_BAR; }
        if constexpr (!Epi::AFTER_DRAIN) { E(acc, cur, wr, wc, fr, fq); S.done(cur); }
        if (!has_next) break;
#pragma unroll
        for (int a = 0; a < 2; ++a)
#pragma unroll
            for (int b = 0; b < 2; ++b)
#pragma unroll
                for (int m = 0; m < 4; ++m)
#pragma unroll
                    for (int n = 0; n < 2; ++n) acc[a][b][m][n] = (f32x4){0.f, 0.f, 0.f, 0.f};
        cur = nxt; cA = nA; cB = nB; ++ui;
        if constexpr (ALIGN_EPI) { if (wr == 1) PG8_BAR; }
    }
    PG8_WAIT_V(0);
    if constexpr (!ALIGN_EPI) { if (wr == 0) PG8_BAR; }
    PG8_BAR;
    if constexpr (Epi::AFTER_DRAIN) { E.fused(acc, cur, wr, wc, fr, fq, lds, wid, lane); S.done(cur); }
#undef PG8_SA
#undef PG8_SB
#undef PG8_STAGE
#undef PG8_LDA
#undef PG8_LDB
#undef PG8_MMA
#undef PG8_WAIT_V
#undef PG8_WAIT_L
#undef PG8_BAR
#undef PG8_SCHED
}
}
#define LAS __attribute__((address_space(3)))
typedef unsigned short bf16_t;
typedef short bf16x8 __attribute__((ext_vector_type(8)));
typedef float f32x4 __attribute__((ext_vector_type(4)));
typedef unsigned u32x4 __attribute__((ext_vector_type(4)));
typedef unsigned u32x2 __attribute__((ext_vector_type(2)));
constexpr size_t MiB = 1u << 20;
constexpr size_t WS_CTL = 0, WS_COND = 1 * MiB, WS_QB = 1 * MiB + 65536, WS_BIAS1 = 1 * MiB + 98304, WS_PART = 2 * MiB;
constexpr size_t WS_BT1 = 4 * MiB, WS_BT2 = 8 * MiB, WS_BT3 = 10 * MiB, WS_KEYS = 14 * MiB, WS_WSB = 14 * MiB + 524288;
constexpr size_t WS_UFP8 = 16 * MiB, WS_VFP8 = 32 * MiB, WS_HB = 48 * MiB  , WS_YCAT = 80 * MiB, WS_AGLU = 112 * MiB, WS_UG = 128 * MiB, WS_VG = 144 * MiB;
constexpr size_t WS_X1B = 112 * MiB;
constexpr size_t WS_Q = 160 * MiB, WS_EIDX = 240 * MiB, WS_GATE = 248 * MiB;

struct Params {
    const float* in[23];
    float* out;
    unsigned char* ws;
};
enum { I_X = 0, I_C, I_WADA, I_BADA, I_G1, I_WIN, I_BIN, I_CONVW, I_CONVB, I_GCLN, I_BCLN, I_GVLN, I_BVLN, I_WSP, I_BSP, I_WOUT, I_BOUT, I_G2, I_WQ, I_KEYS, I_EU, I_EV, I_GF };

__device__ __forceinline__ unsigned pk_bf16(float lo, float hi) { unsigned r; asm volatile("v_cvt_pk_bf16_f32 %0, %1, %2" : "=v"(r) : "v"(lo), "v"(hi)); return r; }
__device__ __forceinline__ float bf_lo(unsigned w) { return __uint_as_float(w << 16); }
__device__ __forceinline__ float bf_hi(unsigned w) { return __uint_as_float(w & 0xffff0000u); }

typedef float f32x16 __attribute__((ext_vector_type(16)));
typedef float f32x32 __attribute__((ext_vector_type(32)));
typedef unsigned u32x6 __attribute__((ext_vector_type(6)));
#ifndef FMT_U
#define FMT_U 4
#endif
#ifndef FMT_V
#define FMT_V 4
#endif
template <int FMT> struct RowFmt { static constexpr int LB = FMT == 6 ? 24 : 16, RSB = FMT == 6 ? 768 : 512; };
constexpr size_t WS_SU = 1 * MiB + 262144, WS_SV = 1 * MiB + 262144 + 65536;
constexpr size_t WS_USC = 24 * MiB, WS_VSC = 40 * MiB;
__device__ __forceinline__ float half_max(float v) {
    v = fmaxf(v, SWZ(v, 0x401F)); v = fmaxf(v, SWZ(v, 0x201F)); v = fmaxf(v, SWZ(v, 0x101F)); v = fmaxf(v, SWZ(v, 0x081F)); v = fmaxf(v, SWZ(v, 0x041F)); return v;
}
__device__ __forceinline__ int expert_row(int e) { return e ^ ((e & 127) << 7); }
template <int FMT> __device__ __forceinline__ void convert_row_from(const float4 (&xl)[8], unsigned char* __restrict__ dst, float* __restrict__ side, int l32);
template <int FMT> __device__ __forceinline__ void convert_row(const float* __restrict__ src, unsigned char* __restrict__ dst, float* __restrict__ side, int l32) {
    float4 xl[8];
#pragma unroll
    for (int j = 0; j < 8; ++j) xl[j] = *(const float4*)(src + 128 * j + 4 * l32);
    __builtin_amdgcn_sched_barrier(0);
    convert_row_from<FMT>(xl, dst, side, l32);
}
template <int FMT> __device__ __forceinline__ void convert_row_from(const float4 (&xl)[8], unsigned char* __restrict__ dst, float* __restrict__ side, int l32) {
    float v[32]; float am = 0.f;
#pragma unroll
    for (int j = 0; j < 8; ++j) { const float4 x = xl[j]; v[4 * j] = x.x; v[4 * j + 1] = x.y; v[4 * j + 2] = x.z; v[4 * j + 3] = x.w;
        am = fmaxf(am, fmaxf(fmaxf(fabsf(x.x), fabsf(x.y)), fmaxf(fabsf(x.z), fabsf(x.w)))); }
    if constexpr (FMT == 6) {
        am = half_max(am);
        const float s = fmaxf(am, 1e-30f) * (1.f / 7.5f), inv = 1.f / s;
        f32x16 a, b;
#pragma unroll
        for (int m = 0; m < 16; ++m) { a[m] = v[m] * inv; b[m] = v[16 + m] * inv; }
        const u32x6 w = __builtin_amdgcn_cvt_scalef32_2xpk16_fp6_f32(a, b, 1.0f);
        u32x4 w0; w0.x = w[0]; w0.y = w[1]; w0.z = w[2]; w0.w = w[3]; u32x2 w1; w1.x = w[4]; w1.y = w[5];
        *(u32x4*)(dst + 24 * l32) = w0; *(u32x2*)(dst + 24 * l32 + 16) = w1;
        if (l32 == 0) *side = s;
    } else {
        const unsigned sb = pk_bf16(fmaxf(am, 1e-30f) * (1.f / 6.f), 0.f) & 0xffffu;
        const float s = __uint_as_float(sb << 16), inv = 1.f / s;
        u32x4 w; unsigned* wp = (unsigned*)&w;
#pragma unroll
        for (int d = 0; d < 4; ++d) { unsigned x = 0u;
            x = __builtin_amdgcn_cvt_scalef32_pk_fp4_f32(x, v[8 * d + 0] * inv, v[8 * d + 1] * inv, 1.0f, 0);
            x = __builtin_amdgcn_cvt_scalef32_pk_fp4_f32(x, v[8 * d + 2] * inv, v[8 * d + 3] * inv, 1.0f, 1);
            x = __builtin_amdgcn_cvt_scalef32_pk_fp4_f32(x, v[8 * d + 4] * inv, v[8 * d + 5] * inv, 1.0f, 2);
            x = __builtin_amdgcn_cvt_scalef32_pk_fp4_f32(x, v[8 * d + 6] * inv, v[8 * d + 7] * inv, 1.0f, 3);
            wp[d] = x; }
        *(u32x4*)(dst + 16 * l32) = w;
        ((unsigned short*)side)[l32] = (unsigned short)sb;
    }
}
template <int FMT> struct RowData;
template <> struct RowData<6> { u32x4 a; u32x2 b; };
template <> struct RowData<4> { u32x4 a; unsigned short sc; };
template <int FMT> __device__ __forceinline__ RowData<FMT> row_load(const unsigned char* p  , const unsigned char* psc  ) {
    RowData<FMT> r;
    if constexpr (FMT == 6) { r.a = *(const u32x4*)p; r.b = *(const u32x2*)(p + 16); }
    else { r.a = *(const u32x4*)p; r.sc = *(const unsigned short*)psc; }
    return r;
}
template <int FMT> __device__ __forceinline__ void row_decode(const RowData<FMT>& r, f32x2 (&o)[16], float& bscale) {
    if constexpr (FMT == 6) {
        u32x6 w; w[0] = r.a.x; w[1] = r.a.y; w[2] = r.a.z; w[3] = r.a.w; w[4] = r.b.x; w[5] = r.b.y;
        const f32x32 f = __builtin_amdgcn_cvt_scalef32_pk32_f32_fp6(w, 1.0f);
#pragma unroll
        for (int m = 0; m < 16; ++m) o[m] = (f32x2){f[2 * m], f[2 * m + 1]};
        bscale = 1.f;
    } else {
        const unsigned* wp = (const unsigned*)&r.a;
#pragma unroll
        for (int d = 0; d < 4; ++d) { o[4 * d + 0] = __builtin_amdgcn_cvt_scalef32_pk_f32_fp4(wp[d], 1.0f, 0); o[4 * d + 1] = __builtin_amdgcn_cvt_scalef32_pk_f32_fp4(wp[d], 1.0f, 1);
            o[4 * d + 2] = __builtin_amdgcn_cvt_scalef32_pk_f32_fp4(wp[d], 1.0f, 2); o[4 * d + 3] = __builtin_amdgcn_cvt_scalef32_pk_f32_fp4(wp[d], 1.0f, 3); }
        bscale = __uint_as_float((unsigned)r.sc << 16);
    }
}
__device__ __forceinline__ float reduce8_half(const float (&s)[8], int lane) {
    const bool b4 = lane & 16, b3 = lane & 8, b2 = lane & 4;
    float u[4];
#pragma unroll
    for (int k = 0; k < 4; ++k) { const float keep = b4 ? s[k + 4] : s[k], send = b4 ? s[k] : s[k + 4]; u[k] = keep + SWZ(send, 0x401F); }
    float v[2];
#pragma unroll
    for (int k = 0; k < 2; ++k) { const float keep = b3 ? u[k + 2] : u[k], send = b3 ? u[k] : u[k + 2]; v[k] = keep + SWZ(send, 0x201F); }
    const float keep = b2 ? v[1] : v[0], send = b2 ? v[0] : v[1];
    float w = keep + SWZ(send, 0x101F);
    w += SWZ(w, 0x081F); w += SWZ(w, 0x041F);
    return w;
}
typedef int i32x8 __attribute__((ext_vector_type(8)));
typedef _Float16 h16x2 __attribute__((ext_vector_type(2)));
__device__ __forceinline__ void convert_row_umx_from(const float4 (&xl)[8], unsigned char* __restrict__ dst, unsigned char* __restrict__ sdst, int l32);
__device__ __forceinline__ void convert_row_umx(const float* __restrict__ src, unsigned char* __restrict__ dst, unsigned char* __restrict__ sdst, int l32) {
    float4 xl[8];
#pragma unroll
    for (int j = 0; j < 8; ++j) xl[j] = *(const float4*)(src + 32 * l32 + 4 * j);
    __builtin_amdgcn_sched_barrier(0);
    convert_row_umx_from(xl, dst, sdst, l32);
}
__device__ __forceinline__ void convert_row_umx_from(const float4 (&xl)[8], unsigned char* __restrict__ dst, unsigned char* __restrict__ sdst, int l32) {
    float v[32]; float am = 0.f;
#pragma unroll
    for (int j = 0; j < 8; ++j) { v[4 * j] = xl[j].x; v[4 * j + 1] = xl[j].y; v[4 * j + 2] = xl[j].z; v[4 * j + 3] = xl[j].w;
        am = fmaxf(am, fmaxf(fmaxf(fabsf(xl[j].x), fabsf(xl[j].y)), fmaxf(fabsf(xl[j].z), fabsf(xl[j].w)))); }
    am = fmaxf(am, 1e-30f);
    const int bits = __float_as_int(am * (1.f / 6.f));
    const int e_up = ((bits >> 23) & 255) - 127 + ((bits & 0x7fffff) ? 1 : 0);
    const float s_dn = __int_as_float((e_up - 1 + 127) << 23);
    int e = (am <= 7.f * s_dn) ? e_up - 1 : e_up;
    e = e < -120 ? -120 : (e > 120 ? 120 : e);
    const float inv = __int_as_float((127 - e) << 23);
    u32x4 w; unsigned* wp = (unsigned*)&w;
#pragma unroll
    for (int d = 0; d < 4; ++d) { unsigned x = 0u;
        x = __builtin_amdgcn_cvt_scalef32_pk_fp4_f32(x, v[8 * d + 0] * inv, v[8 * d + 1] * inv, 1.0f, 0);
        x = __builtin_amdgcn_cvt_scalef32_pk_fp4_f32(x, v[8 * d + 2] * inv, v[8 * d + 3] * inv, 1.0f, 1);
        x = __builtin_amdgcn_cvt_scalef32_pk_fp4_f32(x, v[8 * d + 4] * inv, v[8 * d + 5] * inv, 1.0f, 2);
        x = __builtin_amdgcn_cvt_scalef32_pk_fp4_f32(x, v[8 * d + 6] * inv, v[8 * d + 7] * inv, 1.0f, 3);
        wp[d] = x; }
    *(u32x4*)(dst + 16 * l32) = w;
    sdst[8 * (l32 & 3) + (l32 >> 2)] = (unsigned char)(e + 127);
}

__device__ __forceinline__ void peer_sort_pairs(int& eX, int& eY, float& gX, float& gY, bool desc, LAS unsigned char* scr, int lane) {
    const int bx = eX >> 10, by = eY >> 10;
    int base = 0, posX = 0, posY = 0;
#pragma nounroll
    for (int b = 0; b < 16; ++b) {
        const unsigned long long balX = __ballot(bx == b), balY = __ballot(by == b);
        const int cX = __popcll(balX), cY = __popcll(balY);
        const int mX = __builtin_amdgcn_mbcnt_hi((unsigned)(balX >> 32), __builtin_amdgcn_mbcnt_lo((unsigned)balX, 0u)), mY = __builtin_amdgcn_mbcnt_hi((unsigned)(balY >> 32), __builtin_amdgcn_mbcnt_lo((unsigned)balY, 0u));
        posX = bx == b ? base + mX : posX; posY = by == b ? base + cX + mY : posY;
        base += cX + cY;
    }
    if (desc) { posX = 127 - posX; posY = 127 - posY; }
    u32x2 wX; wX.x = (unsigned)eX; wX.y = __float_as_uint(gX); u32x2 wY; wY.x = (unsigned)eY; wY.y = __float_as_uint(gY);
    *(LAS u32x2*)(scr + 8 * posX) = wX; *(LAS u32x2*)(scr + 8 * posY) = wY;
    asm volatile("s_waitcnt lgkmcnt(0)" ::: "memory");
    const u32x2 rX = *(const LAS u32x2*)(scr + 8 * lane), rY = *(const LAS u32x2*)(scr + 8 * (64 + lane));
    asm volatile("s_waitcnt lgkmcnt(0)" ::: "memory");
    eX = (int)rX.x; gX = __uint_as_float(rX.y); eY = (int)rY.x; gY = __uint_as_float(rY.y);
}
__device__ __forceinline__ int bperm_off(int addr, int src, const int off) { int r; asm volatile("ds_bpermute_b32 %0, %1, %2 offset:%3" : "=v"(r) : "v"(addr), "v"(src), "i"(off)); return r; }
__device__ __forceinline__ float sel_mask(float a, float b, unsigned long long m) { float r; asm("v_cndmask_b32_e64 %0, %1, %2, %3" : "=v"(r) : "v"(a), "v"(b), "s"(m)); return r; }
constexpr int PEER_LDS_TAB = 7168 * 4;
constexpr int PEER_HS = 2080 + 4096 + 1024;
template <int PMODE> __device__ __forceinline__ void phase_peer(const Params& P, float* ldsf, int bid, int nblk, float* xout) {
    constexpr int LBV = RowFmt<FMT_V>::LB, RSV = RowFmt<FMT_V>::RSB, RSU = 512;
    const unsigned char* usct = P.ws + WS_USC; const unsigned char* vsct = P.ws + WS_VSC;
    const float* cond = (const float*)(P.ws + WS_COND); const float* part = (const float*)(P.ws + WS_PART);
    const int* eidx = (const int*)(P.ws + WS_EIDX); const float* gate = (const float*)(P.ws + WS_GATE);
    const unsigned char* utab = P.ws + WS_UFP8; const unsigned char* vtab = P.ws + WS_VFP8;
    float* xio = P.out;
    const int tid = phase_tid(), lane = tid & 63, wave = tid >> 6, l32 = lane & 31, hf = lane >> 5, li = lane & 15, lg = lane >> 4;
    float* G2 = ldsf; float* SH2 = ldsf + 2048; float* GT2 = ldsf + 4096; float* GF = ldsf + 6144;
    LAS unsigned char* hs = (LAS unsigned char*)ldsf + PEER_LDS_TAB + wave * PEER_HS;
    for (int i = tid; i < 2048; i += 512) { const int b = i >> 10, d = i & 1023;
        G2[i] = P.in[I_G2][d] * (1.f + cond[b * 6 * D + 4 * D + d]); SH2[i] = cond[b * 6 * D + 3 * D + d]; GT2[i] = cond[b * 6 * D + 5 * D + d]; }
    for (int i = tid; i < 1024; i += 512) GF[i] = P.in[I_GF][i];
    if (lane < 8) *(LAS unsigned*)(hs + 2048 + 4 * lane) = 0u;
    __syncthreads();
    const int hb_base = li < 8 ? ((li & 1) * 1024 + 16 * lg) : 2048, hb_step = li < 8 ? 128 : 0, hb_hi = li < 8 ? 64 : 16;
    const int hf4 = 4 * hf, hf8 = 8 * hf, li4 = 4 * li, gaddr = 4 * (4 * lg + (li >> 1));
    const unsigned long long rm1 = __ballot((li >> 1) == 1), rm2 = __ballot((li >> 1) == 2), rm3 = __ballot((li >> 1) >= 3);
    const int sbv = 127;
    u32x4 ub[8]; u32x2 usc; RowData<FMT_V> vb[2][8];
    int t = bid * 8 + wave;
    int eA = 0, eB = 0; float gA = 0.f, gB = 0.f;
    int eAn = 0, eBn = 0; float gAn = 0.f, gBn = 0.f;
    if (t < T) { eA = eidx[(size_t)t * 128 + lane]; eB = eidx[(size_t)t * 128 + 64 + lane]; gA = gate[(size_t)t * 128 + lane]; gB = gate[(size_t)t * 128 + 64 + lane];
        const int t1 = (t + nblk * 8 < T) ? t + nblk * 8 : t;
        eAn = eidx[(size_t)t1 * 128 + lane]; eBn = eidx[(size_t)t1 * 128 + 64 + lane]; gAn = gate[(size_t)t1 * 128 + lane]; gBn = gate[(size_t)t1 * 128 + 64 + lane];
        peer_sort_pairs(eA, eB, gA, gB, false, hs + 2080 + 4096, lane); }
    int tk = 0;
#define PEER_EL(eS_, gg) bperm_off(li4, eS_, ((gg) & 3) << 6)
#define PEER_ISSUE_U(el_) do { \
            const unsigned char* rb_ = utab + (size_t)((unsigned)el_ * (unsigned)RSU + 16u * (unsigned)lg);         \
            _Pragma("unroll") for (int c = 0; c < 8; ++c) ub[c] = *(const u32x4*)(rb_ + 64 * c); usc = *(const u32x2*)(usct + (size_t)((unsigned)el_ * 32u + 8u * (unsigned)lg)); } while (0)
#define PEER_EV(eS_, gg, p) bperm_off(hf4, eS_, ((((gg) & 3) << 4) + 2 * (p)) << 2)
#define PEER_ISSUE_V1(bf, ev_, p) do { vb[bf][p] = row_load<FMT_V>(vtab + (size_t)((unsigned)(ev_) * (unsigned)RSV + (unsigned)(LBV * l32)), vsct + (size_t)((unsigned)(ev_) * 64u + 2u * (unsigned)l32)); } while (0)
    if (t < T) {
        { int el_ = PEER_EL(eA, 0); asm volatile("s_waitcnt lgkmcnt(0)" : "+v"(el_)); PEER_ISSUE_U(el_); }
#pragma unroll
        for (int p = 0; p < 8; ++p) { int ev_ = PEER_EV(eA, 0, p); asm volatile("s_waitcnt lgkmcnt(0)" : "+v"(ev_)); PEER_ISSUE_V1(0, ev_, p); }
#pragma unroll
        for (int p = 0; p < 8; ++p) { int ev_ = PEER_EV(eA, 1, p); asm volatile("s_waitcnt lgkmcnt(0)" : "+v"(ev_)); PEER_ISSUE_V1(1, ev_, p); } }
    for (; t < T; t += nblk * 8) {
        const int b = t >> 13;
        const bf16_t* xrow = (const bf16_t*)(P.ws + WS_X1B) + (size_t)t * D;
        peer_sort_pairs(eAn, eBn, gAn, gBn, ((tk + 1) & 1) != 0, hs + 2080 + 4096, lane);
        const int tn = (t + 2 * nblk * 8 < T) ? t + 2 * nblk * 8 : t;
        const int eAnn = __builtin_nontemporal_load(eidx + (size_t)tn * 128 + lane), eBnn = __builtin_nontemporal_load(eidx + (size_t)tn * 128 + 64 + lane); const float gAnn = __builtin_nontemporal_load(gate + (size_t)tn * 128 + lane), gBnn = __builtin_nontemporal_load(gate + (size_t)tn * 128 + 64 + lane);
        const float4* pp = (const float4*)(part + (size_t)t * 16);
        const float4 q0 = pp[0], q1 = pp[1], q2 = pp[2], q3 = pp[3];
        float4 xl[4];
#pragma unroll
        for (int j = 0; j < 2; ++j) { const u32x4 xv_ = __builtin_nontemporal_load((const u32x4*)(xrow + 16 * lane + 8 * j));
            xl[2 * j].x = bf_lo(xv_.x); xl[2 * j].y = bf_hi(xv_.x); xl[2 * j].z = bf_lo(xv_.y); xl[2 * j].w = bf_hi(xv_.y); xl[2 * j + 1].x = bf_lo(xv_.z); xl[2 * j + 1].y = bf_hi(xv_.z); xl[2 * j + 1].z = bf_lo(xv_.w); xl[2 * j + 1].w = bf_hi(xv_.w); }
        __builtin_amdgcn_sched_barrier(0);
        const float ss = (((q0.x + q0.y) + (q0.z + q0.w)) + ((q1.x + q1.y) + (q1.z + q1.w))) + (((q2.x + q2.y) + (q2.z + q2.w)) + ((q3.x + q3.y) + (q3.z + q3.w)));
        const float r = rsqrtf(ss * (1.f / D) + EPS);
        {
            u32x4 whi, wlo; unsigned* ph = (unsigned*)&whi; unsigned* pl = (unsigned*)&wlo;
#pragma unroll
            for (int j = 0; j < 4; ++j) { const float4 g4 = *(const float4*)(G2 + b * 1024 + 16 * lane + 4 * j), s4 = *(const float4*)(SH2 + b * 1024 + 16 * lane + 4 * j);
                const float h0 = xl[j].x * r * g4.x + s4.x, h1 = xl[j].y * r * g4.y + s4.y, h2v = xl[j].z * r * g4.z + s4.z, h3 = xl[j].w * r * g4.w + s4.w;
                int wh = 0; wh = __builtin_amdgcn_cvt_pk_fp8_f32(h0, h1, wh, false); wh = __builtin_amdgcn_cvt_pk_fp8_f32(h2v, h3, wh, true);
                const f32x2 d01 = __builtin_amdgcn_cvt_pk_f32_fp8(wh, false), d23 = __builtin_amdgcn_cvt_pk_f32_fp8(wh, true);
                int wl = 0; wl = __builtin_amdgcn_cvt_pk_fp8_f32((h0 - d01.x), (h1 - d01.y), wl, false); wl = __builtin_amdgcn_cvt_pk_fp8_f32((h2v - d23.x), (h3 - d23.y), wl, true);
                ph[j] = (unsigned)wh; pl[j] = (unsigned)wl; }
            *(LAS u32x4*)(hs + 16 * lane) = whi; *(LAS u32x4*)(hs + 1024 + 16 * lane) = wlo;
#pragma unroll
            for (int j = 0; j < 4; ++j) *(LAS f32x4*)(hs + 2080 + 4 * (16 * lane + 4 * j)) = (f32x4){xl[j].x, xl[j].y, xl[j].z, xl[j].w};
        }
        asm volatile("s_waitcnt lgkmcnt(0)" ::: "memory");
        h16x2 o[16];
#pragma unroll
        for (int m = 0; m < 16; ++m) o[m] = (h16x2){(_Float16)0.f, (_Float16)0.f};
#pragma unroll
        for (int g = 0; g < 8; ++g) {
            constexpr int dummy_ = 0; (void)dummy_;
            const int bf = g & 1;
            int eln_ = g < 7 ? PEER_EL((((g + 1) & 4) ? eB : eA), g + 1) : PEER_EL(eAn, 0);
            int gq_ = bperm_off(gaddr, __float_as_int((g & 4) ? gB : gA), (g & 3) << 6);
            f32x4 acc = {0.f, 0.f, 0.f, 0.f};
#pragma unroll
            for (int hh = 0; hh < 2; ++hh) {
                i32x8 hB[4];
#pragma unroll
                for (int c4 = 0; c4 < 4; ++c4) { const int c = 4 * hh + c4; const u32x4 lo4 = *(const LAS u32x4*)(hs + hb_base + c * hb_step), hi4 = *(const LAS u32x4*)(hs + hb_base + c * hb_step + hb_hi);
                    hB[c4][0] = lo4.x; hB[c4][1] = lo4.y; hB[c4][2] = lo4.z; hB[c4][3] = lo4.w; hB[c4][4] = hi4.x; hB[c4][5] = hi4.y; hB[c4][6] = hi4.z; hB[c4][7] = hi4.w; }
#pragma unroll
                for (int c4 = 0; c4 < 4; ++c4) { const int c = 4 * hh + c4; i32x8 a8; a8[0] = (int)ub[c].x; a8[1] = (int)ub[c].y; a8[2] = (int)ub[c].z; a8[3] = (int)ub[c].w; a8[4] = 0; a8[5] = 0; a8[6] = 0; a8[7] = 0;
                    const int sa = (int)(hh == 0 ? usc.x : usc.y);
                    switch (c4) {
                        case 0: acc = __builtin_amdgcn_mfma_scale_f32_16x16x128_f8f6f4(a8, hB[c4], acc, 4, 0, 0, sa, 0, sbv); break;
                        case 1: acc = __builtin_amdgcn_mfma_scale_f32_16x16x128_f8f6f4(a8, hB[c4], acc, 4, 0, 1, sa, 0, sbv); break;
                        case 2: acc = __builtin_amdgcn_mfma_scale_f32_16x16x128_f8f6f4(a8, hB[c4], acc, 4, 0, 2, sa, 0, sbv); break;
                        default: acc = __builtin_amdgcn_mfma_scale_f32_16x16x128_f8f6f4(a8, hB[c4], acc, 4, 0, 3, sa, 0, sbv); break; } }
            }
            __builtin_amdgcn_sched_barrier(0);
            asm volatile("s_waitcnt lgkmcnt(0)" : "+v"(eln_), "+v"(gq_));
            PEER_ISSUE_U(eln_);
            __builtin_amdgcn_sched_barrier(0);
            float accs = acc[0];
            accs = sel_mask(accs, acc[1], rm1); accs = sel_mask(accs, acc[2], rm2); accs = sel_mask(accs, acc[3], rm3);
            const float dsum = accs + SWZ(accs, 0x041F);
            const float actv = gelu_fast(dsum) * __int_as_float(gq_);
#define PEER_AV(p) bperm_off(hf8, __float_as_int(actv), (16 * ((p) >> 1) + 2 * ((2 * (p)) & 3)) << 2)
#define PEER_EVN(p) (g < 6 ? PEER_EV((((g + 2) & 4) ? eB : eA), g + 2, p) : PEER_EV(eAn, g - 6, p))
            int an_ = PEER_AV(0); int en_ = PEER_EVN(0);
#pragma unroll
            for (int p = 0; p < 8; ++p) {
                asm volatile("s_waitcnt lgkmcnt(0)" : "+v"(an_), "+v"(en_));
                const float acur = __int_as_float(an_); const int ecur = en_;
                if (p < 7) { an_ = PEER_AV(p + 1); en_ = PEER_EVN(p + 1); }
                h16x2 dv[16]; const unsigned* wp = (const unsigned*)&vb[bf][p].a;
#pragma unroll
                for (int d = 0; d < 4; ++d) { dv[4 * d + 0] = __builtin_amdgcn_cvt_scalef32_pk_f16_fp4(wp[d], 1.0f, 0); dv[4 * d + 1] = __builtin_amdgcn_cvt_scalef32_pk_f16_fp4(wp[d], 1.0f, 1);
                    dv[4 * d + 2] = __builtin_amdgcn_cvt_scalef32_pk_f16_fp4(wp[d], 1.0f, 2); dv[4 * d + 3] = __builtin_amdgcn_cvt_scalef32_pk_f16_fp4(wp[d], 1.0f, 3); }
                const float bs = __uint_as_float((unsigned)vb[bf][p].sc << 16);
                const _Float16 ah = (_Float16)(acur * bs); const h16x2 aa = {ah, ah};
                __builtin_amdgcn_sched_barrier(0);
                PEER_ISSUE_V1(bf, ecur, p);
                __builtin_amdgcn_sched_barrier(0);
#pragma unroll
                for (int m = 0; m < 16; ++m) o[m] = __builtin_elementwise_fma(dv[m], aa, o[m]); }
#undef PEER_AV
#undef PEER_EVN
            __builtin_amdgcn_sched_barrier(0);
        }

        float sq = 0.f; float4 xr[8];
#pragma unroll
        for (int j = 0; j < 8; ++j) { const f32x4 xv_ = *(const LAS f32x4*)(hs + 2080 + 4 * (128 * j + 4 * l32)); xr[j].x = xv_[0]; xr[j].y = xv_[1]; xr[j].z = xv_[2]; xr[j].w = xv_[3]; }
        __builtin_amdgcn_sched_barrier(0);
#pragma unroll
        for (int j = 0; j < 8; ++j) { const float4 g4 = *(const float4*)(GT2 + b * 1024 + 128 * j + 4 * l32);
            float ov[4] = {(float)o[2 * j].x, (float)o[2 * j].y, (float)o[2 * j + 1].x, (float)o[2 * j + 1].y};
#pragma unroll
            for (int i = 0; i < 4; ++i) { auto rr = __builtin_amdgcn_permlane32_swap(__float_as_uint(ov[i]), __float_as_uint(ov[i]), false, false); ov[i] = __uint_as_float(rr[0]) + __uint_as_float(rr[1]); }
            xr[j].x += g4.x * ov[0]; xr[j].y += g4.y * ov[1]; xr[j].z += g4.z * ov[2]; xr[j].w += g4.w * ov[3];
            sq += (xr[j].x * xr[j].x + xr[j].y * xr[j].y) + (xr[j].z * xr[j].z + xr[j].w * xr[j].w); }
        sq += SWZ(sq, 0x401F); sq += SWZ(sq, 0x201F); sq += SWZ(sq, 0x101F); sq += SWZ(sq, 0x081F); sq += SWZ(sq, 0x041F);
        const float rr = rsqrtf(sq * (1.f / D) + EPS);
#pragma unroll
        for (int j = 0; j < 8; ++j) if ((j >> 2) == hf) { const float4 g4 = *(const float4*)(GF + 128 * j + 4 * l32);
            float4 ov; ov.x = xr[j].x * rr * g4.x; ov.y = xr[j].y * rr * g4.y; ov.z = xr[j].z * rr * g4.z; ov.w = xr[j].w * rr * g4.w;
            __builtin_nontemporal_store((f32x4){ov.x, ov.y, ov.z, ov.w}, (f32x4*)(xout + (size_t)t * D + 128 * j + 4 * l32)); }
        eA = eAn; eB = eBn; gA = gAn; gB = gBn; eAn = eAnn; eBn = eBnn; gAn = gAnn; gBn = gBnn; ++tk;
    }
#undef PEER_ISSUE_U
#undef PEER_ISSUE_V1
#undef PEER_EV
#undef PEER_EL
}

__device__ __forceinline__ int inproj_row(int n) {
    const int sec = n >> 9, m = n & 511;
    return (sec >> 1) * 1024 + (m >> 7) * 256 + (sec & 1) * 128 + (m & 127);
}
template <int MODE> __device__ __forceinline__ void transpose_tile(const float* __restrict__ W, int K, int N, bf16_t* __restrict__ Bt, int k0, int n0, float* tile  ) {
    const int tid = threadIdx.x;
#pragma unroll
    for (int p = 0; p < 2; ++p) { const int kk = p * 32 + (tid >> 4), nn = (tid & 15) * 4;
        const float4 v = *(const float4*)(W + (size_t)(k0 + kk) * N + n0 + nn);
        tile[kk * 65 + nn] = v.x; tile[kk * 65 + nn + 1] = v.y; tile[kk * 65 + nn + 2] = v.z; tile[kk * 65 + nn + 3] = v.w; }
    __syncthreads();
    { const int n = tid >> 3, kc = (tid & 7) * 8; const float* s = tile + kc * 65 + n;
      u32x4 o; o.x = pk_bf16(s[0], s[65]); o.y = pk_bf16(s[2 * 65], s[3 * 65]); o.z = pk_bf16(s[4 * 65], s[5 * 65]); o.w = pk_bf16(s[6 * 65], s[7 * 65]);
      const int row = MODE == 1 ? inproj_row(n0 + n) : (n0 + n);
      *(u32x4*)(Bt + (size_t)row * K + k0 + kc) = o; }
    __syncthreads();
}
__device__ __forceinline__ void phase0(const Params& P, float* ldsf, int bid, int nblk) {
    const int tid = phase_tid(), lane = tid & 63, wave = tid >> 6;
    unsigned char* ws = P.ws;
    for (int citem = bid; citem < 192; citem += nblk) {
        float* sl = ldsf;
        float* red = ldsf + 2048;
        for (int i = tid; i < 2048; i += 512) { const float cv = P.in[I_C][i]; sl[i] = cv * __builtin_amdgcn_rcpf(1.f + __builtin_amdgcn_exp2f(-1.4426950408889634f * cv)); }
        __syncthreads();
        const int c = tid & 31, kp = tid >> 5, n = citem * 32 + c;
        float a0 = 0.f, a1 = 0.f;
        const float* wp = P.in[I_WADA] + (size_t)(kp * 64) * 6144 + n;
#pragma unroll 8
        for (int k = 0; k < 64; ++k) { const float w = wp[(size_t)k * 6144]; a0 += sl[kp * 64 + k] * w; a1 += sl[1024 + kp * 64 + k] * w; }
        red[kp * 32 + c] = a0; red[512 + kp * 32 + c] = a1;
        __syncthreads();
        if (tid < 64) { const int b = tid >> 5, cc = tid & 31; float s = 0.f;
#pragma unroll
            for (int j = 0; j < 16; ++j) s += red[b * 512 + j * 32 + cc];
            ((float*)(ws + WS_COND))[b * 6144 + citem * 32 + cc] = s + P.in[I_BADA][citem * 32 + cc]; }
        __syncthreads();
    }
    for (int it = bid; it < 1280; it += nblk) {
        if (it < 512) transpose_tile<1>(P.in[I_WIN], 1024, 2048, (bf16_t*)(ws + WS_BT1), (it >> 5) * 64, (it & 31) * 64, ldsf);
        else if (it < 768) { const int r = it - 512; transpose_tile<0>(P.in[I_WOUT], 1024, 1024, (bf16_t*)(ws + WS_BT2), (r >> 4) * 64, (r & 15) * 64, ldsf); }
        else { const int r = it - 768; transpose_tile<0>(P.in[I_WQ], 1024, 2048, (bf16_t*)(ws + WS_BT3), (r >> 5) * 64, (r & 31) * 64, ldsf); }
    }
    const int gt = bid * 512 + tid, ngt = nblk * 512;
    for (int i = gt; i < 2048; i += ngt) ((float*)(ws + WS_BIAS1))[inproj_row(i)] = P.in[I_BIN][i];
    for (int i = gt; i < 8 * 2 * 128 * 128 / 4; i += ngt) { const float4 v = *(const float4*)(P.in[I_KEYS] + (size_t)i * 4); u32x2 o; o.x = pk_bf16(v.x, v.y); o.y = pk_bf16(v.z, v.w); *(u32x2*)((bf16_t*)(ws + WS_KEYS) + (size_t)i * 4) = o; }
    for (int i = gt; i < 8 * 128 * 128 / 4; i += ngt) { const int e = i * 4, s = e & 127, t = (e >> 7) & 127; float4 v = *(const float4*)(P.in[I_WSP] + (size_t)e);
        v.x = (s + 0 <= t) ? v.x : 0.f; v.y = (s + 1 <= t) ? v.y : 0.f; v.z = (s + 2 <= t) ? v.z : 0.f; v.w = (s + 3 <= t) ? v.w : 0.f;
        u32x2 o; o.x = pk_bf16(v.x, v.y); o.y = pk_bf16(v.z, v.w); *(u32x2*)((bf16_t*)(ws + WS_WSB) + (size_t)e) = o; }
    if (nblk != 256) { const int l32 = lane & 31, hf = lane >> 5;
      for (int r2 = bid * 8 + wave; r2 < NEXP / 2; r2 += nblk * 8) { const int r = 2 * r2 + hf;
          const int rr_ = expert_row(r);
          convert_row_umx(P.in[I_EU] + (size_t)r * D, ws + WS_UFP8 + (size_t)rr_ * 512, ws + WS_USC + (size_t)rr_ * 32, l32);
          convert_row<FMT_V>(P.in[I_EV] + (size_t)r * D, ws + WS_VFP8 + (size_t)rr_ * RowFmt<FMT_V>::RSB, (float*)(ws + WS_VSC + (size_t)rr_ * 64), l32); } }
}
__device__ __forceinline__ void phase0b(const Params& P, float* ldsf, int bid, int nblk) {
    const int tid = phase_tid(), lane = tid & 63, wave = tid >> 6;
    unsigned char* ws = P.ws; const float* cond = (const float*)(ws + WS_COND);
    float* G1 = ldsf; float* SH1 = ldsf + 2048;
    for (int i = tid; i < 2048; i += 512) { const int b = i >> 10, d = i & 1023; G1[i] = P.in[I_G1][d] * (1.f + cond[b * 6144 + 1024 + d]); SH1[i] = cond[b * 6144 + d]; }
    __syncthreads();
    {
        for (int n = bid * 8 + wave; n < 2048; n += nblk * 8) {
            const bf16_t* brow = (const bf16_t*)(ws + WS_BT3) + (size_t)n * 1024;
            float a0 = 0.f, a1 = 0.f;
#pragma unroll
            for (int j = 0; j < 2; ++j) { const u32x4 w = *(const u32x4*)(brow + j * 512 + lane * 8); const int k = j * 512 + lane * 8;
                const float wv[8] = {bf_lo(w.x), bf_hi(w.x), bf_lo(w.y), bf_hi(w.y), bf_lo(w.z), bf_hi(w.z), bf_lo(w.w), bf_hi(w.w)};
#pragma unroll
                for (int e = 0; e < 8; ++e) { a0 += wv[e] * cond[3 * 1024 + k + e]; a1 += wv[e] * cond[6144 + 3 * 1024 + k + e]; } }
            a0 = wave_sum(a0); a1 = wave_sum(a1);
            if (lane == 0) { ((float*)(ws + WS_QB))[n] = a0; ((float*)(ws + WS_QB))[2048 + n] = a1; }
        }
    }
    const float* x = P.in[I_X]; bf16_t* hb = (bf16_t*)(ws + WS_HB);
    for (int t = bid * 8 + wave; t < T; t += nblk * 8) {
        const int b = t >> 13;
        float4 v[4]; float s = 0.f;
#pragma unroll
        for (int j = 0; j < 4; ++j) { v[j] = *(const float4*)(x + (size_t)t * D + 256 * j + 4 * lane); s += (v[j].x * v[j].x + v[j].y * v[j].y) + (v[j].z * v[j].z + v[j].w * v[j].w); }
        s = wave_sum(s);
        const float r = rsqrtf(s * (1.f / D) + EPS);
#pragma unroll
        for (int j = 0; j < 4; ++j) { const float4 g4 = *(const float4*)(G1 + b * 1024 + 256 * j + 4 * lane), s4 = *(const float4*)(SH1 + b * 1024 + 256 * j + 4 * lane);
            u32x2 o; o.x = pk_bf16(v[j].x * r * g4.x + s4.x, v[j].y * r * g4.y + s4.y); o.y = pk_bf16(v[j].z * r * g4.z + s4.z, v[j].w * r * g4.w + s4.w);
            *(u32x2*)(hb + (size_t)t * D + 256 * j + 4 * lane) = o; }
    }
}
__device__ __forceinline__ void conv_item(const Params& P, int item, int lane) {
    const int rb = item >> 3, g = item & 7, c = g * 64 + lane, t0 = rb * 32, s0 = t0 & (SEQ - 1);
    const bf16_t* aglu = (const bf16_t*)(P.ws + WS_AGLU); bf16_t* ycat = (bf16_t*)(P.ws + WS_YCAT);
    float a[62];
    unsigned short raw[62];
#pragma unroll
    for (int i = 0; i < 62; ++i) { const int tr = (s0 - 30 + i) >= 0 ? (t0 - 30 + i) : t0; raw[i] = aglu[(size_t)tr * 512 + c]; }
    __builtin_amdgcn_sched_barrier(0);
#pragma unroll
    for (int i = 0; i < 62; ++i) a[i] = (s0 - 30 + i) >= 0 ? __uint_as_float((unsigned)raw[i] << 16) : 0.f;
    float w[31];
#pragma unroll
    for (int k = 0; k < 31; ++k) w[k] = P.in[I_CONVW][k * 512 + c];
    const float cb = P.in[I_CONVB][c], gl = P.in[I_GCLN][c], bl = P.in[I_BCLN][c];
    float y[32];
#pragma unroll
    for (int i = 0; i < 32; ++i) { float acc = cb;
#pragma unroll
        for (int k = 0; k < 31; ++k) acc += w[k] * a[i + k];
        y[i] = acc; }
#pragma unroll
    for (int hh = 0; hh < 2; ++hh) {
        float s16[16];
#pragma unroll
        for (int i = 0; i < 16; ++i) s16[i] = y[16 * hh + i];
        const float sm = reduce16(s16, lane);
        float d[16];
#pragma unroll
        for (int i = 0; i < 16; ++i) { const float mean = __int_as_float(__builtin_amdgcn_readlane(__float_as_int(sm), 4 * i)) * (1.f / 64.f); d[i] = y[16 * hh + i] - mean; s16[i] = d[i] * d[i]; }
        const float sv = reduce16(s16, lane);
#pragma unroll
        for (int i = 0; i < 16; ++i) { const float var = __int_as_float(__builtin_amdgcn_readlane(__float_as_int(sv), 4 * i)) * (1.f / 64.f);
            const float z = d[i] * rsqrtf(var + EPS) * gl + bl;
            const float o = z * __builtin_amdgcn_rcpf(1.f + __builtin_amdgcn_exp2f(-1.4426950408889634f * z));
            ycat[(size_t)(t0 + 16 * hh + i) * 1024 + c] = (bf16_t)(pk_bf16(o, 0.f) & 0xffffu); }
    }
}
constexpr int MIX_RS = 136;
__device__ __forceinline__ void mix_item(const Params& P, int item, LAS bf16_t* vnT  , int lane) {
    const int chunk = item >> 3, h = item & 7, tb = chunk * 128, cb = h * 64;
    const bf16_t* ug = (const bf16_t*)(P.ws + WS_UG); const bf16_t* vg = (const bf16_t*)(P.ws + WS_VG); const bf16_t* wsb = (const bf16_t*)(P.ws + WS_WSB) + (size_t)h * 128 * 128;
    bf16_t* ycat = (bf16_t*)(P.ws + WS_YCAT);
    const int fr = lane & 15, fq = lane >> 4;
    bf16x8 wf[8][4]; float bsv[8];
#pragma unroll
    for (int mt = 0; mt < 8; ++mt) { bsv[mt] = P.in[I_BSP][h * 128 + 16 * mt + fr];
#pragma unroll
        for (int ks = 0; ks < 4; ++ks) if (ks <= (mt >> 1)) wf[mt][ks] = *(const bf16x8*)(wsb + (size_t)(16 * mt + fr) * 128 + 32 * ks + 8 * fq); }
    { const int rr = lane >> 3, pc = lane & 7;
      float gl[8], bl[8];
#pragma unroll
      for (int j = 0; j < 8; ++j) { gl[j] = P.in[I_GVLN][cb + pc * 8 + j]; bl[j] = P.in[I_BVLN][cb + pc * 8 + j]; }
      u32x4 wv[16];
#pragma unroll
      for (int it = 0; it < 16; ++it) wv[it] = *(const u32x4*)(vg + (size_t)(tb + it * 8 + rr) * 512 + cb + pc * 8);
      __builtin_amdgcn_sched_barrier(0);
#pragma unroll
      for (int it = 0; it < 16; ++it) { const int t = it * 8 + rr;
          const u32x4 w = wv[it];
          float v[8] = {bf_lo(w.x), bf_hi(w.x), bf_lo(w.y), bf_hi(w.y), bf_lo(w.z), bf_hi(w.z), bf_lo(w.w), bf_hi(w.w)};
          float s = 0.f, ss = 0.f;
#pragma unroll
          for (int j = 0; j < 8; ++j) { s += v[j]; ss += v[j] * v[j]; }
          s += __shfl_xor(s, 1); ss += __shfl_xor(ss, 1); s += __shfl_xor(s, 2); ss += __shfl_xor(ss, 2); s += __shfl_xor(s, 4); ss += __shfl_xor(ss, 4);
          const float mean = s * (1.f / 64.f), var = fmaxf(ss * (1.f / 64.f) - mean * mean, 0.f), rstd = rsqrtf(var + EPS);
#pragma unroll
          for (int j = 0; j < 8; ++j) { const float o = (v[j] - mean) * rstd * gl[j] + bl[j]; vnT[(pc * 8 + j) * MIX_RS + t] = (bf16_t)(pk_bf16(o, 0.f) & 0xffffu); } }
    }
    u32x2 uwa[8][4];
#pragma unroll
    for (int mt = 0; mt < 8; ++mt)
#pragma unroll
        for (int nf = 0; nf < 4; ++nf) uwa[mt][nf] = *(const u32x2*)(ug + (size_t)(tb + 16 * mt + fr) * 512 + cb + 16 * fq + 4 * nf);
    asm volatile("s_waitcnt lgkmcnt(0)" ::: "memory");
#pragma unroll
    for (int mt = 0; mt < 8; ++mt) {
        f32x4 acc[4];
#pragma unroll
        for (int nf = 0; nf < 4; ++nf) acc[nf] = (f32x4){0.f, 0.f, 0.f, 0.f};
        const int t = 16 * mt + fr; const size_t ro = (size_t)(tb + t);
        const u32x2 (&uw)[4] = uwa[mt];
#pragma unroll
        for (int ks = 0; ks < 4; ++ks) if (ks <= (mt >> 1)) {
#pragma unroll
            for (int nf = 0; nf < 4; ++nf) { const bf16x8 vf = *(const LAS bf16x8*)(vnT + (16 * (fr >> 2) + 4 * nf + (fr & 3)) * MIX_RS + 32 * ks + 8 * fq);
                acc[nf] = __builtin_amdgcn_mfma_f32_16x16x32_bf16(vf, wf[mt][ks], acc[nf], 0, 0, 0); }
        }
        const float bs = bsv[mt];
#pragma unroll
        for (int nf = 0; nf < 4; ++nf) {
            u32x2 o; o.x = pk_bf16(bf_lo(uw[nf].x) * (acc[nf][0] + bs), bf_hi(uw[nf].x) * (acc[nf][1] + bs)); o.y = pk_bf16(bf_lo(uw[nf].y) * (acc[nf][2] + bs), bf_hi(uw[nf].y) * (acc[nf][3] + bs));
            *(u32x2*)(ycat + ro * 1024 + 512 + cb + 16 * fq + 4 * nf) = o; }
    }
}
__device__ __forceinline__ void phase1b(const Params& P, LAS unsigned char* lds, int bid, int nblk) {
    const int tid = phase_tid(), lane = tid & 63, wave = tid >> 6;
    LAS bf16_t* vnT = (LAS bf16_t*)lds + wave * 64 * MIX_RS;
    const int gw = bid * 8 + wave, ngw = nblk * 8;
    if (ngw == 2048) {
        if (gw < 1024) { mix_item(P, gw, vnT, lane); conv_item(P, gw, lane); }
        else { conv_item(P, gw, lane); conv_item(P, gw + 1024, lane); conv_item(P, gw + 2048, lane); }
    } else {
        for (int it = gw; it < 1024; it += ngw) mix_item(P, it, vnT, lane);
        for (int it = gw; it < 4096; it += ngw) conv_item(P, it, lane);
    }
}
constexpr int LDS_DYN = 147456;
template <int WHICH> __device__ __forceinline__ void phase_gemm(const Params& P, LAS unsigned char* lds, int bid, int nblk) {
    unsigned char* ws = P.ws;
    if constexpr (WHICH == 1) {
        pg8::Gemm g{(const bf16_t*)(ws + WS_HB), (const bf16_t*)(ws + WS_BT1), T, 2048, 1024}; pg8::StaticOrder S; S.init(T, 2048, nblk, bid);
        pg8::EpiInProj E{(const float*)(ws + WS_BIAS1), (bf16_t*)(ws + WS_AGLU), (bf16_t*)(ws + WS_UG), (bf16_t*)(ws + WS_VG)};
        pg8::gemm_phase<pg8::EpiInProj, pg8::StaticOrder, true, true>(lds, g, S, E);
    } else if constexpr (WHICH == 2) {
        pg8::Gemm g{(const bf16_t*)(ws + WS_YCAT), (const bf16_t*)(ws + WS_BT2), T, 1024, 1024}; pg8::StaticOrder S; S.init(T, 1024, nblk, bid);
        pg8::EpiOutProj E{P.in[I_X], P.in[I_BOUT], (const float*)(ws + WS_COND), P.in[I_G2], (bf16_t*)(ws + WS_X1B), (bf16_t*)(ws + WS_HB), (float*)(ws + WS_PART)};
        pg8::gemm_phase<pg8::EpiOutProj, pg8::StaticOrder, true, true>(lds, g, S, E);
    } else {
        pg8::Gemm g{(const bf16_t*)(ws + WS_HB), (const bf16_t*)(ws + WS_BT3), T, 2048, 1024}; pg8::StaticOrder S; S.init(T, 2048, nblk, bid);
        pg8::EpiQuery E{(const float*)(ws + WS_PART), (const float*)(ws + WS_QB), (bf16_t*)(ws + WS_Q)};
        pg8::gemm_phase<pg8::EpiQuery, pg8::StaticOrder, true, true>(lds, g, S, E);
    }
}
__device__ __forceinline__ int mono(int u) { return u ^ ((u >> 31) & 0x7fffffff); }
template <int N> __device__ __forceinline__ void bitonic_sort_desc(int (&a)[N]) {
#pragma unroll
    for (int k = 2; k <= N; k <<= 1)
#pragma unroll
        for (int j = k >> 1; j > 0; j >>= 1)
#pragma unroll
            for (int i = 0; i < N; ++i) { const int l = i ^ j;
                if (l > i) { const int hi = max(a[i], a[l]), lo = min(a[i], a[l]); if ((i & k) == 0) { a[i] = hi; a[l] = lo; } else { a[i] = lo; a[l] = hi; } } }
}
__device__ __forceinline__ void sort16_desc(int (&a)[16]) {
#define CE(i, j) { const int hi_ = max(a[i], a[j]), lo_ = min(a[i], a[j]); a[i] = hi_; a[j] = lo_; }
    CE(0,13) CE(1,12) CE(2,15) CE(3,14) CE(4,8) CE(5,6) CE(7,11) CE(9,10)
    CE(0,5) CE(1,7) CE(2,9) CE(3,4) CE(6,13) CE(8,14) CE(10,15) CE(11,12)
    CE(0,1) CE(2,3) CE(4,5) CE(6,8) CE(7,9) CE(10,11) CE(12,13) CE(14,15)
    CE(0,2) CE(1,3) CE(4,10) CE(5,11) CE(6,7) CE(8,9) CE(12,14) CE(13,15)
    CE(1,2) CE(3,12) CE(4,6) CE(5,7) CE(8,10) CE(9,11) CE(13,14)
    CE(1,4) CE(2,6) CE(5,8) CE(7,10) CE(9,13) CE(11,14)
    CE(2,4) CE(3,6) CE(9,12) CE(11,13)
    CE(3,5) CE(6,8) CE(7,9) CE(10,12)
    CE(3,4) CE(5,6) CE(7,8) CE(9,10) CE(11,12)
    CE(6,7) CE(8,9)
#undef CE
}
__device__ __forceinline__ void merge_top16(int (&a)[16], const int (&b)[16]) {
#pragma unroll
    for (int j = 0; j < 16; ++j) a[j] = max(a[j], b[15 - j]);
#pragma unroll
    for (int j = 8; j > 0; j >>= 1)
#pragma unroll
        for (int i = 0; i < 16; ++i) { const int l = i ^ j; if (l > i) { const int hi = max(a[i], a[l]), lo = min(a[i], a[l]); a[i] = hi; a[l] = lo; } }
}
__device__ __forceinline__ void merge_quad(int (&a)[16]) {
    int b[16];
#pragma unroll
    for (int j = 0; j < 16; ++j) b[j] = __builtin_amdgcn_ds_swizzle(a[j], 0x401F);
    merge_top16(a, b);
#pragma unroll
    for (int j = 0; j < 16; ++j) b[j] = __shfl_xor(a[j], 32);
    merge_top16(a, b);
}
__device__ __forceinline__ int sel4(int fq, int x0, int x1, int x2, int x3) { const int lo = (fq & 1) ? x1 : x0, hi = (fq & 1) ? x3 : x2; return (fq & 2) ? hi : lo; }
__device__ constexpr int cand_ab(int fq, int s) {
    if (fq == 0) return (0 << 4) | s;
    if (fq == 1) return s < 8 ? ((1 << 4) | s) : (s < 13 ? ((2 << 4) | (s - 8)) : -1);
    if (fq == 2) return s < 4 ? ((3 << 4) | s) : (s < 7 ? ((4 << 4) | (s - 4)) : (s < 9 ? ((5 << 4) | (s - 7)) : (s < 11 ? ((6 << 4) | (s - 9)) : (s < 13 ? ((7 << 4) | (s - 11)) : -1))));
    return s < 8 ? (((8 + s) << 4) | 0) : -1;
}
constexpr int TK_RS = 136;
__device__ __forceinline__ void phase3c(const Params& P, LAS unsigned char* lds, int bid, int nblk) {
    const int tid = phase_tid(), lane = tid & 63, wave = tid >> 6, fr = lane & 15, fq = lane >> 4;
    LAS bf16_t* kl = (LAS bf16_t*)lds;
    LAS unsigned char* isc = lds + 2 * 128 * TK_RS * 2 + wave * 512;
    const bf16_t* q = (const bf16_t*)(P.ws + WS_Q); const bf16_t* keysb = (const bf16_t*)(P.ws + WS_KEYS);
    int* eidx = (int*)(P.ws + WS_EIDX); float* gate = (float*)(P.ws + WS_GATE);
    int cur_h = -1;
    bf16x8 qf[2][4];
#define TK_LOADQ(dst, it_) do { const int h_ = (it_) & 7, t0_ = ((it_) >> 3) * 128 + wave * 16; \
        _Pragma("unroll") for (int i_ = 0; i_ < 2; ++i_) _Pragma("unroll") for (int ks_ = 0; ks_ < 4; ++ks_) dst[i_][ks_] = *(const bf16x8*)(q + (size_t)(t0_ + fr) * 2048 + h_ * 256 + i_ * 128 + 32 * ks_ + 8 * fq); } while (0)
    if (bid < 1024) TK_LOADQ(qf, bid);
    for (int item = bid; item < 1024; item += nblk) {
        const int h = item & 7, tile = item >> 3;
        bf16x8 qn[2][4]; const int nitem = item + nblk < 1024 ? item + nblk : item;
        TK_LOADQ(qn, nitem);
        const bool cv = (nblk == 256); const int cv_r = 2 * ((bid * 8 + wave) * 4 + (item >> 8)) + (lane >> 5), cv_l = lane & 31;
        float4 cu[8], cw[8];
        if (cv) {
#pragma unroll
            for (int j = 0; j < 8; ++j) cu[j] = *(const float4*)(P.in[I_EU] + (size_t)cv_r * D + 32 * cv_l + 4 * j);
#pragma unroll
            for (int j = 0; j < 8; ++j) cw[j] = *(const float4*)(P.in[I_EV] + (size_t)cv_r * D + 128 * j + 4 * cv_l);
        }
        __builtin_amdgcn_sched_barrier(0);
        if (h != cur_h) {
            __syncthreads();
            for (int c = tid; c < 4096; c += 512) { const int row = c >> 4, pc = c & 15;
                const u32x4 v = *(const u32x4*)(keysb + ((size_t)h * 256 + row) * 128 + pc * 8);
                *(LAS u32x4*)(kl + row * TK_RS + pc * 8) = v; }
            __syncthreads();
            cur_h = h;
        }
        const int t0 = tile * 128 + wave * 16;
        int L[2][16];
#pragma unroll
        for (int i = 0; i < 2; ++i) {
            f32x4 S[8];
#pragma unroll
            for (int nf = 0; nf < 8; ++nf) { S[nf] = (f32x4){0.f, 0.f, 0.f, 0.f};
#pragma unroll
                for (int ks = 0; ks < 4; ++ks) { const bf16x8 kf = *(const LAS bf16x8*)(kl + (i * 128 + 16 * nf + fr) * TK_RS + 32 * ks + 8 * fq);
                    S[nf] = __builtin_amdgcn_mfma_f32_16x16x32_bf16(kf, qf[i][ks], S[nf], 0, 0, 0); } }
            int a0[16], a1[16];
#pragma unroll
            for (int nf = 0; nf < 4; ++nf)
#pragma unroll
                for (int r = 0; r < 4; ++r) { a0[4 * nf + r] = (mono(__float_as_int(S[nf][r])) & ~127) | (16 * nf + 4 * fq + r);
                                              a1[4 * nf + r] = (mono(__float_as_int(S[nf + 4][r])) & ~127) | (16 * (nf + 4) + 4 * fq + r); }
            sort16_desc(a0); sort16_desc(a1);
            merge_top16(a0, a1);
            merge_quad(a0);
#pragma unroll
            for (int j = 0; j < 16; ++j) L[i][j] = a0[j];
        }
        if (fq < 2) {
            u32x4 w; unsigned* wp = (unsigned*)&w;
#pragma unroll
            for (int d = 0; d < 4; ++d) { const int x0 = fq ? L[1][4 * d] : L[0][4 * d], x1 = fq ? L[1][4 * d + 1] : L[0][4 * d + 1], x2 = fq ? L[1][4 * d + 2] : L[0][4 * d + 2], x3 = fq ? L[1][4 * d + 3] : L[0][4 * d + 3];
                wp[d] = (unsigned)(x0 & 127) | ((unsigned)(x1 & 127) << 8) | ((unsigned)(x2 & 127) << 16) | ((unsigned)(x3 & 127) << 24); }
            *(LAS u32x4*)(isc + fr * 32 + fq * 16) = w;
        }
        int cnd[16];
#pragma unroll
        for (int s = 0; s < 16; ++s) {
            constexpr int NEG = (int)0x80000000;
            const int c0 = cand_ab(0, s), c1 = cand_ab(1, s), c2 = cand_ab(2, s), c3 = cand_ab(3, s);
            const int ka = sel4(fq, L[0][c0 >> 4], c1 >= 0 ? L[0][(c1 >> 4) & 15] : 0, c2 >= 0 ? L[0][(c2 >> 4) & 15] : 0, c3 >= 0 ? L[0][(c3 >> 4) & 15] : 0);
            const int kb = sel4(fq, L[1][c0 & 15], c1 >= 0 ? L[1][c1 & 15] : 0, c2 >= 0 ? L[1][c2 & 15] : 0, c3 >= 0 ? L[1][c3 & 15] : 0);
            const int code = sel4(fq, c0, c1, c2, c3);
            const float sum = __int_as_float(mono(ka & ~127)) + __int_as_float(mono(kb & ~127));
            const int key = (mono(__float_as_int(sum)) & ~255) | (code & 255);
            cnd[s] = code < 0 ? NEG : key;
        }
        sort16_desc(cnd);
        merge_quad(cnd);
        const float vmax = __int_as_float(mono(cnd[0] & ~255));
        int kk[4]; float ee[4]; float esum = 0.f;
#pragma unroll
        for (int j = 0; j < 4; ++j) { kk[j] = sel4(fq, cnd[j], cnd[4 + j], cnd[8 + j], cnd[12 + j]);
            ee[j] = __builtin_amdgcn_exp2f((__int_as_float(mono(kk[j] & ~255)) - vmax) * 1.4426950408889634f); esum += ee[j]; }
        esum += __int_as_float(__builtin_amdgcn_ds_swizzle(__float_as_int(esum), 0x401F)); esum += __shfl_xor(esum, 32);
        const float rs = __builtin_amdgcn_rcpf(esum);
        asm volatile("s_waitcnt lgkmcnt(0)" ::: "memory");
        int4 eo; float4 go; int* ep = (int*)&eo; float* gp = (float*)&go;
#pragma unroll
        for (int j = 0; j < 4; ++j) { const int code = kk[j] & 255; const int ia = isc[fr * 32 + (code >> 4)], ib = isc[fr * 32 + 16 + (code & 15)]; ep[j] = ((ia ^ ib) << 7) | ib; gp[j] = ee[j] * rs; }
        *(int4*)(eidx + (size_t)(t0 + fr) * 128 + h * 16 + 4 * fq) = eo;
        *(float4*)(gate + (size_t)(t0 + fr) * 128 + h * 16 + 4 * fq) = go;
        if (cv) { const int cv_w = expert_row(cv_r);
                  convert_row_umx_from(cu, P.ws + WS_UFP8 + (size_t)cv_w * 512, P.ws + WS_USC + (size_t)cv_w * 32, cv_l);
                  convert_row_from<FMT_V>(cw, P.ws + WS_VFP8 + (size_t)cv_w * RowFmt<FMT_V>::RSB, (float*)(P.ws + WS_VSC + (size_t)cv_w * 64), cv_l); }
#pragma unroll
        for (int i_ = 0; i_ < 2; ++i_)
#pragma unroll
            for (int ks_ = 0; ks_ < 4; ++ks_) qf[i_][ks_] = qn[i_][ks_];
    }
#undef TK_LOADQ
    __syncthreads();
}
#define XB_TMO      128
#define XB_XCNT(j)  (256  + 64 * (j))
#define XB_XSUB(j)  (1280 + 64 * (j))
#define XB_XGEN(j)  (2304 + 64 * (j))
#define XB_TOP      3328
#define XB_TOPGEN   3392
#define XCD_BAR_WORDS 3456
#define XB_SPIN_CAP (1u << 18)

__device__ __forceinline__ unsigned xb_ld(unsigned* p)              { return __hip_atomic_load(p, __ATOMIC_RELAXED, __HIP_MEMORY_SCOPE_AGENT); }
__device__ __forceinline__ unsigned xb_add(unsigned* p, unsigned v) { return __hip_atomic_fetch_add(p, v, __ATOMIC_RELAXED, __HIP_MEMORY_SCOPE_AGENT); }
__device__ __forceinline__ unsigned xb_xcc_id() { return (unsigned)__builtin_amdgcn_s_getreg((3 << 11) | 20) & 0xFu; }
#define XB_SPIN(cond, bar) do { unsigned _sp = 0; while (cond) { __builtin_amdgcn_s_sleep(1); \
    if ((++_sp & 255u) == 0u) { if (xb_ld(&(bar)[XB_TMO])) break; if (_sp > XB_SPIN_CAP) { atomicAdd(&(bar)[XB_TMO], 1u); break; } } } } while (0)

struct XcdBarrier {
    unsigned* bar; unsigned x;
    volatile LAS unsigned* st;
};

__device__ __forceinline__ XcdBarrier xcd_barrier_post(unsigned* bar, volatile LAS unsigned* st) {
    XcdBarrier b; b.bar = bar; b.x = xb_xcc_id(); b.st = st;
    if (threadIdx.x == 0) (void)xb_add(&bar[XB_XCNT(b.x)], 1u);
    return b;
}
__device__ __forceinline__ void xcd_barrier_complete(unsigned* bar, unsigned x, unsigned& nloc, unsigned& nx) {
    const unsigned G = gridDim.x * gridDim.y * gridDim.z;
    unsigned sum, cnt, mine, sp = 0u;
    for (;;) {
        sum = 0u; cnt = 0u; mine = 0u;
#pragma unroll
        for (unsigned j = 0; j < 16; ++j) { const unsigned c = xb_ld(&bar[XB_XCNT(j)]); sum += c; cnt += (c > 0u) ? 1u : 0u; mine = (j == x) ? c : mine; }
        if (sum == G) break;
        __builtin_amdgcn_s_sleep(1);
        if ((++sp & 255u) == 0u) { if (xb_ld(&bar[XB_TMO])) break; if (sp > XB_SPIN_CAP) { atomicAdd(&bar[XB_TMO], 1u); break; } }
    }
    nloc = mine > 0u ? mine : 1u; nx = cnt > 0u ? cnt : 1u;
}

__device__ __forceinline__ void xcd_barrier(const XcdBarrier& b) {
    asm volatile("s_waitcnt vmcnt(0)" ::: "memory");
    __syncthreads();
    if (threadIdx.x == 0) {
        unsigned* bar = b.bar;
        __builtin_amdgcn_s_waitcnt(0);
        unsigned nloc = b.st[0], nx = b.st[1];
        if (nloc == 0u) { xcd_barrier_complete(bar, b.x, nloc, nx); b.st[0] = nloc; b.st[1] = nx; }
        const unsigned old = xb_add(&bar[XB_XSUB(b.x)], 1u);
        const unsigned gen = old / nloc;
        if (old + 1u == (gen + 1u) * nloc) {
            __builtin_amdgcn_fence(__ATOMIC_RELEASE, "agent");
            asm volatile("s_waitcnt vmcnt(0)" ::: "memory");
            const unsigned og = xb_add(&bar[XB_TOP], 1u);
            const unsigned tg = og / nx;
            if (og + 1u == (tg + 1u) * nx) xb_add(&bar[XB_TOPGEN], 1u);
            else XB_SPIN(xb_ld(&bar[XB_TOPGEN]) == tg, bar);
            __builtin_amdgcn_fence(__ATOMIC_ACQUIRE, "agent");
            xb_add(&bar[XB_XGEN(b.x)], 1u);
            asm volatile("s_waitcnt vmcnt(0)" ::: "memory");
        } else {
            XB_SPIN(xb_ld(&bar[XB_XGEN(b.x)]) == gen, bar);
            __builtin_amdgcn_fence(__ATOMIC_ACQUIRE, "agent");
            asm volatile("s_waitcnt vmcnt(0)" ::: "memory");
        }
    }
    __syncthreads();
}

constexpr int LDS_BARST = LDS_DYN - 64;
constexpr int CW_BAR = 1024;
constexpr size_t CTL_ZERO_BYTES = 32768;
__global__ void __launch_bounds__(512, 2) k_mega(Params P) {
    extern __shared__ __attribute__((aligned(16))) unsigned char lds[];
    LAS unsigned char* l3 = (LAS unsigned char*)lds;
    const int bid = blockIdx.x, nblk = gridDim.x;
    volatile LAS unsigned* st = (volatile LAS unsigned*)(l3 + LDS_BARST);
    if (threadIdx.x < 2) st[threadIdx.x] = 0u;
    __syncthreads();
    XcdBarrier bar = xcd_barrier_post((unsigned*)(P.ws + WS_CTL) + CW_BAR, st);
#define GRID_BAR() do { xcd_barrier(bar); } while (0)
#ifndef REP_MASK
#define REP_MASK 0
#endif
#define RUN(k, call) do { call; GRID_BAR(); if (REP_MASK & (1 << (k))) { call; GRID_BAR(); } } while (0)
    RUN(0, phase0(P, (float*)lds, bid, nblk));
    RUN(1, phase0b(P, (float*)lds, bid, nblk));
    RUN(2, phase_gemm<1>(P, l3, bid, nblk));
    RUN(3, phase1b(P, l3, bid, nblk));
    RUN(4, phase_gemm<2>(P, l3, bid, nblk));
    RUN(5, phase_gemm<3>(P, l3, bid, nblk));
    RUN(6, phase3c(P, l3, bid, nblk));
#undef RUN
#ifdef PEER_PROBE
    phase_peer<PEER_PROBE>(P, (float*)lds, bid, nblk, (float*)(P.ws + WS_Q));
    GRID_BAR();
#endif
    phase_peer<0>(P, (float*)lds, bid, nblk, P.out);
#undef GRID_BAR
}

extern "C" void kernel_launch(void* const* d_in, const int* in_sizes, int n_in, void* d_out, int out_size, void* d_ws, size_t ws_size, hipStream_t stream) {
    if (n_in != 23 || ws_size < 256 * MiB) { fprintf(stderr, "kernel_launch: unexpected n_in %d or ws_size %zu\n", n_in, ws_size); return; }
    static int grid = 0;
    if (grid == 0) {
        int dev = 0, cus = 0;
        if (hipGetDevice(&dev) != hipSuccess || hipDeviceGetAttribute(&cus, hipDeviceAttributeMultiprocessorCount, dev) != hipSuccess || cus <= 0) { fprintf(stderr, "kernel_launch: device query failed\n"); grid = -1; return; }
        if (hipFuncSetAttribute((const void*)k_mega, hipFuncAttributeMaxDynamicSharedMemorySize, LDS_DYN) != hipSuccess) { fprintf(stderr, "kernel_launch: hipFuncSetAttribute failed\n"); grid = -1; return; }
        int per_cu = 0;
        if (hipOccupancyMaxActiveBlocksPerMultiprocessor(&per_cu, (const void*)k_mega, 512, LDS_DYN) != hipSuccess || per_cu < 1) { fprintf(stderr, "kernel_launch: occupancy query says %d blocks/CU\n", per_cu); }
        (void)hipGetLastError();
        grid = cus;
    }
    if (grid < 0) return;
    Params P{};
    for (int i = 0; i < 23; ++i) P.in[i] = (const float*)d_in[i];
    P.out = (float*)d_out; P.ws = (unsigned char*)d_ws;
    hipMemsetAsync((char*)d_ws + WS_CTL, 0, CTL_ZERO_BYTES, stream);
    hipLaunchKernelGGL(k_mega, dim3(grid), dim3(512), LDS_DYN, stream, P);
}
```
